# Optimizing an MI355X kernel written in HIP

```python
import jax, jax.numpy as jnp
from jax import lax
import numpy as np

D_MODEL = 4096
BATCH = 1
SEQ = 16384
DEPTH = 2

N_META = 16
MIX_W = D_MODEL
M_HEADS = 4
M_W = MIX_W // 2
M_V = M_W // M_HEADS
M_QK = M_V // 2
M_CHUNK = 64
CONV_W = 4
A_HEADS = 16
A_W = MIX_W - M_W
A_V = A_W // A_HEADS
NOPE = 128
ROPE = 64
Q_LORA = 1536
KV_LORA = 512
Q_BLOCK = 128
ROPE_THETA = 10000.0
NORM_EPS = 1e-6
D_FF = -(-8 * D_MODEL // (3 * 256)) * 256
IN_SIZES = (M_HEADS * M_QK, M_HEADS * M_QK, M_W, M_W, M_HEADS, M_HEADS, Q_LORA, KV_LORA, ROPE)
N_IN = sum(IN_SIZES)
NEG_SCORE = -1e30

kernel_name = 'hybrid_mlstm_mla_meta_block'


def rmsnorm(x, g):
    xf = x.astype(jnp.float32)
    y = xf * lax.rsqrt(jnp.mean(xf * xf, axis=-1, keepdims=True) + NORM_EPS)
    return (y * g.astype(jnp.float32)).astype(x.dtype)


def split_cols(z):
    idx, acc = [], 0
    for s in IN_SIZES[:-1]:
        acc += s
        idx.append(acc)
    return jnp.split(z, idx, axis=-1)


def apply_rope(x, cos, sin):
    half = x.shape[-1] // 2
    x1 = x[..., :half].astype(jnp.float32)
    x2 = x[..., half:].astype(jnp.float32)
    return jnp.concatenate([x1 * cos - x2 * sin, x1 * sin + x2 * cos], axis=-1).astype(x.dtype)


def causal_dwconv(x, w):
    k_w, c = w.shape
    return lax.conv_general_dilated(x, w[:, None, :].astype(x.dtype), window_strides=(1,),
                                    padding=((k_w - 1, 0),), dimension_numbers=('NWC', 'WIO', 'NWC'),
                                    feature_group_count=c)


def mlstm_chunkwise(q, k, v, log_i, log_f):
    B, H, Lp, dk = q.shape
    dv = v.shape[-1]
    nc = Lp // M_CHUNK

    def chunks(t):
        return jnp.moveaxis(t.reshape(B, H, nc, M_CHUNK, *t.shape[3:]), 2, 0)

    tril = jnp.tril(jnp.ones((M_CHUNK, M_CHUNK), dtype=bool))

    def step(carry, xs):
        C, n, m = carry
        qc, kc, vc, li, lf = xs
        qf = qc.astype(jnp.float32)
        kf = kc.astype(jnp.float32)
        vf = vc.astype(jnp.float32)
        b = jnp.cumsum(lf, axis=-1)
        g = b[..., -1]
        d = jnp.where(tril, b[..., :, None] - b[..., None, :] + li[..., None, :], -jnp.inf)
        inter = b + m[..., None]
        m_t = jnp.maximum(inter, jnp.max(d, axis=-1))
        w_inter = jnp.exp(inter - m_t)
        s = jnp.einsum('bhtd,bhsd->bhts', qf, kf) * jnp.exp(d - m_t[..., None])
        num = w_inter[..., None] * jnp.einsum('bhtd,bhde->bhte', qf, C) + jnp.einsum('bhts,bhse->bhte', s, vf)
        den = w_inter * jnp.einsum('bhtd,bhd->bht', qf, n) + jnp.sum(s, axis=-1)
        h = num / jnp.maximum(jnp.abs(den), jnp.exp(-m_t))[..., None]
        a = g[..., None] - b + li
        m_new = jnp.maximum(g + m, jnp.max(a, axis=-1))
        decay = jnp.exp(g + m - m_new)
        wk = kf * jnp.exp(a - m_new[..., None])[..., None]
        C_new = decay[..., None, None] * C + jnp.einsum('bhsd,bhse->bhde', wk, vf)
        n_new = decay[..., None] * n + jnp.sum(wk, axis=2)
        return (C_new, n_new, m_new), h

    init = (jnp.zeros((B, H, dk, dv), jnp.float32), jnp.zeros((B, H, dk), jnp.float32),
            jnp.zeros((B, H), jnp.float32))
    xs = (chunks(q), chunks(k), chunks(v), chunks(log_i), chunks(log_f))
    _, h = lax.scan(step, init, xs)
    return jnp.moveaxis(h, 0, 2).reshape(B, H, Lp, dv)


def mlstm_group(q_in, k_in, v_in, o_pre, i_pre, f_pre, conv_w, b_gates, g_mnorm):
    B, L, _ = v_in.shape
    qk = jax.nn.silu(causal_dwconv(jnp.concatenate([q_in, k_in], axis=-1), conv_w))
    q, k = jnp.split(qk, 2, axis=-1)
    pad = (-L) % M_CHUNK

    def heads(t, dim):
        t = t.reshape(B, L, M_HEADS, dim).transpose(0, 2, 1, 3)
        return jnp.pad(t, ((0, 0), (0, 0), (pad, 0), (0, 0)))

    def gate_pad(t, fill):
        return jnp.pad(jnp.transpose(t, (0, 2, 1)), ((0, 0), (0, 0), (pad, 0)), constant_values=fill)

    log_i = gate_pad(i_pre.astype(jnp.float32) + b_gates[:M_HEADS].astype(jnp.float32), -jnp.inf)
    log_f = gate_pad(jax.nn.log_sigmoid(f_pre.astype(jnp.float32) + b_gates[M_HEADS:].astype(jnp.float32)), 0.0)
    h = mlstm_chunkwise(heads(q, M_QK) * (M_QK ** -0.5), heads(k, M_QK), heads(v_in, M_V), log_i, log_f)
    h = h[:, :, pad:].transpose(0, 2, 1, 3)
    h = rmsnorm(h, g_mnorm.reshape(M_HEADS, M_V))
    return (jax.nn.sigmoid(o_pre.astype(jnp.float32)) * h.reshape(B, L, M_W)).astype(v_in.dtype)


def mla_group(c_q, c_kv, k_rope, g_cq, w_uq, g_ckv, w_ukv, cos, sin):
    B, L, _ = c_q.shape
    q = (rmsnorm(c_q, g_cq) @ w_uq).reshape(B, L, A_HEADS, NOPE + ROPE)
    q = jnp.concatenate([q[..., :NOPE], apply_rope(q[..., NOPE:], cos[:, None, :], sin[:, None, :])], axis=-1)
    kv = (rmsnorm(c_kv, g_ckv) @ w_ukv).reshape(B, L, A_HEADS, NOPE + A_V)
    kr = apply_rope(k_rope, cos, sin)
    k = jnp.concatenate([kv[..., :NOPE], jnp.broadcast_to(kr[:, :, None, :], (B, L, A_HEADS, ROPE))], axis=-1)
    v = kv[..., NOPE:]
    pad = (-L) % Q_BLOCK
    Lp = L + pad
    nb = Lp // Q_BLOCK

    def prep(t):
        return jnp.pad(t, ((0, 0), (pad, 0), (0, 0), (0, 0))).transpose(0, 2, 1, 3)

    q, k, v = prep(q), prep(k), prep(v)
    q_blocks = jnp.moveaxis(q.reshape(B, A_HEADS, nb, Q_BLOCK, NOPE + ROPE), 2, 0)
    key_pos = jnp.arange(Lp)
    key_ok = key_pos >= pad
    scale = (NOPE + ROPE) ** -0.5

    def attend(args):
        qb, start = args
        s = jnp.einsum('bhqd,bhkd->bhqk', qb, k, preferred_element_type=jnp.float32) * scale
        q_pos = start + jnp.arange(Q_BLOCK)
        mask = (key_pos[None, :] <= q_pos[:, None]) & key_ok[None, :]
        p = jax.nn.softmax(jnp.where(mask, s, NEG_SCORE), axis=-1)
        return jnp.einsum('bhqk,bhkd->bhqd', p.astype(v.dtype), v)

    o = lax.map(attend, (q_blocks, jnp.arange(nb) * Q_BLOCK))
    o = jnp.moveaxis(o, 0, 2).reshape(B, A_HEADS, Lp, A_V)[:, :, pad:]
    return o.transpose(0, 2, 1, 3).reshape(B, L, A_W)


def hybrid_layer(x, cos, sin, g_mix_pre, w_in, conv_w, b_gates, g_mnorm, g_cq, w_uq, g_ckv, w_ukv,
                 w_out, g_mix_post, g_ffn_pre, w_gu, w_down, g_ffn_post):
    u = rmsnorm(x, g_mix_pre)
    mq, mk, mv, mo, mi, mf, cq, ckv, kr = split_cols(u @ w_in)
    h_m = mlstm_group(mq, mk, mv, mo, mi, mf, conv_w, b_gates, g_mnorm)
    h_a = mla_group(cq, ckv, kr, g_cq, w_uq, g_ckv, w_ukv, cos, sin)
    mix = jnp.concatenate([h_m, h_a.astype(h_m.dtype)], axis=-1) @ w_out
    x = x + rmsnorm(mix, g_mix_post)
    gate, up = jnp.split(rmsnorm(x, g_ffn_pre) @ w_gu, 2, axis=-1)
    y = (jax.nn.silu(gate) * up) @ w_down
    return x + rmsnorm(y, g_ffn_post)


def setup_inputs(seed: int = 0) -> dict:
    key = jax.random.key(seed)
    ks = jax.random.split(key, 20)
    f32 = jnp.float32

    def nrm(k, shape, scale):
        return jax.random.normal(k, shape, f32) * scale

    def gain(k, shape):
        return 1.0 + 0.05 * jax.random.normal(k, shape, f32)

    f_bias = jnp.linspace(3.0, 6.0, M_HEADS, dtype=f32)[None, :] + 0.1 * jax.random.normal(ks[8], (DEPTH, M_HEADS), f32)
    i_bias = 0.1 * jax.random.normal(ks[9], (DEPTH, M_HEADS), f32)
    return {
        'x': nrm(ks[0], (BATCH, SEQ, D_MODEL), 1.0),
        'meta': nrm(ks[1], (N_META, D_MODEL), 1.0),
        'g_mix_pre': gain(ks[2], (DEPTH, D_MODEL)),
        'w_in': nrm(ks[3], (DEPTH, D_MODEL, N_IN), D_MODEL ** -0.5),
        'conv_w': nrm(ks[4], (DEPTH, CONV_W, 2 * M_HEADS * M_QK), CONV_W ** -0.5),
        'b_gates': jnp.concatenate([i_bias, f_bias], axis=-1),
        'g_mnorm': gain(ks[5], (DEPTH, M_W)),
        'g_cq': gain(ks[6], (DEPTH, Q_LORA)),
        'w_uq': nrm(ks[7], (DEPTH, Q_LORA, A_HEADS * (NOPE + ROPE)), Q_LORA ** -0.5),
        'g_ckv': gain(ks[10], (DEPTH, KV_LORA)),
        'w_ukv': nrm(ks[11], (DEPTH, KV_LORA, A_HEADS * (NOPE + A_V)), KV_LORA ** -0.5),
        'w_out': nrm(ks[12], (DEPTH, MIX_W, D_MODEL), MIX_W ** -0.5),
        'g_mix_post': gain(ks[13], (DEPTH, D_MODEL)),
        'g_ffn_pre': gain(ks[14], (DEPTH, D_MODEL)),
        'w_gu': nrm(ks[15], (DEPTH, D_MODEL, 2 * D_FF), D_MODEL ** -0.5),
        'w_down': nrm(ks[16], (DEPTH, D_FF, D_MODEL), D_FF ** -0.5),
        'g_ffn_post': gain(ks[17], (DEPTH, D_MODEL)),
    }


def reference(x, meta, g_mix_pre, w_in, conv_w, b_gates, g_mnorm, g_cq, w_uq, g_ckv, w_ukv,
              w_out, g_mix_post, g_ffn_pre, w_gu, w_down, g_ffn_post):
    B = x.shape[0]
    h = jnp.concatenate([jnp.broadcast_to(meta[None].astype(x.dtype), (B, N_META, D_MODEL)), x], axis=1)
    L = h.shape[1]
    pos = jnp.arange(L, dtype=jnp.float32)
    inv_freq = ROPE_THETA ** (-jnp.arange(ROPE // 2, dtype=jnp.float32) / (ROPE // 2))
    ang = pos[:, None] * inv_freq[None, :]
    cos, sin = jnp.cos(ang), jnp.sin(ang)
    for l in range(DEPTH):
        h = hybrid_layer(h, cos, sin, g_mix_pre[l], w_in[l], conv_w[l], b_gates[l], g_mnorm[l], g_cq[l],
                         w_uq[l], g_ckv[l], w_ukv[l], w_out[l], g_mix_post[l], g_ffn_pre[l], w_gu[l],
                         w_down[l], g_ffn_post[l])
    return h[:, N_META:]
```

```cpp
#include <hip/hip_runtime.h>
#include <cstdio>
#include <cstdint>

#ifndef MK_PER_PHASE
#define MK_PER_PHASE 0
#endif

#define LAS __attribute__((address_space(3)))
typedef unsigned short bf16_t;
typedef short bf16x8 __attribute__((ext_vector_type(8)));
typedef short s16x4 __attribute__((ext_vector_type(4)));
typedef float f32x4 __attribute__((ext_vector_type(4)));
typedef float f32x16 __attribute__((ext_vector_type(16)));
typedef unsigned u32x4 __attribute__((ext_vector_type(4)));
typedef unsigned u32x2 __attribute__((ext_vector_type(2)));

constexpr int DM = 4096, SEQ = 16384, NMETA = 16;
constexpr int RFIRST = 240;
constexpr int R = 16640;
constexpr int NIN = 8448;
constexpr int ZQ = 0, ZK = 1024, ZV = 2048, ZO = 4096, ZCQ = 6144, ZCKV = 7680, ZKR = 8192, ZGI = 8256, ZGF = 8260;
constexpr int NIN_SRC = 8264;
constexpr int QL = 1536, KVL = 512, NQF = 3072, NKVF = 4096;
constexpr int DFF = 11008, NGU = 22016;
constexpr float EPS = 1e-6f;
constexpr int NCHUNK = R / 64;
constexpr int NQB = R / 256;

constexpr size_t MiB = 1u << 20;
constexpr size_t WS_CTL = 0, CTL_BYTES = 1 * MiB;
constexpr size_t WS_COS = 2 * MiB, WS_SIN = 5 * MiB;
constexpr size_t WS_LI = 8 * MiB, WS_LF = 9 * MiB;
constexpr size_t SZ_WIN = (size_t)NIN * DM * 2, SZ_WUQ = (size_t)NQF * QL * 2, SZ_WUKV = (size_t)NKVF * KVL * 2,
                 SZ_WOUT = (size_t)DM * DM * 2, SZ_WGU = (size_t)NGU * DM * 2, SZ_WDN = (size_t)DM * DFF * 2;
constexpr size_t SZ_WL = SZ_WIN + SZ_WUQ + SZ_WUKV + SZ_WOUT + SZ_WGU + SZ_WDN;
constexpr size_t WS_W = 16 * MiB;
constexpr size_t WS_HRES = WS_W + 2 * SZ_WL;
constexpr size_t WS_U = WS_HRES + (size_t)R * DM * 4;
constexpr size_t WS_Z = WS_U + (size_t)R * DM * 2;
constexpr size_t WS_QC = WS_Z + (size_t)R * NIN * 2;
constexpr size_t WS_KC = WS_QC + (size_t)R * 1024 * 2;
constexpr size_t WS_CQN = WS_KC + (size_t)R * 1024 * 2;
constexpr size_t WS_CKVN = WS_CQN + (size_t)R * QL * 2;
constexpr size_t WS_KRR = WS_CKVN + (size_t)R * KVL * 2;
constexpr size_t WS_QF = WS_KRR + (size_t)R * 64 * 2;
constexpr size_t WS_KVF = WS_QF + (size_t)R * NQF * 2;
constexpr size_t WS_HM = WS_KVF + (size_t)R * NKVF * 2;
constexpr size_t WS_HCAT = WS_HM + (size_t)R * 2048 * 4;
constexpr size_t WS_END = WS_HCAT + (size_t)R * DM * 2;
static_assert((size_t)R * DFF * 2 <= WS_CKVN - WS_Z, "act overlay fits in z|qc|kc|cqn");
constexpr int CW_BAR = 4096;
constexpr int CW_Q = 16384;

__device__ __forceinline__ float bf2f(unsigned short b) { return __uint_as_float(((unsigned)b) << 16); }
__device__ __forceinline__ float bflo(unsigned w) { return __uint_as_float(w << 16); }
__device__ __forceinline__ float bfhi(unsigned w) { return __uint_as_float(w & 0xffff0000u); }
__device__ __forceinline__ unsigned cvt_pk_bf16(float lo, float hi) { unsigned r; asm volatile("v_cvt_pk_bf16_f32 %0, %1, %2" : "=v"(r) : "v"(lo), "v"(hi)); return r; }
__device__ __forceinline__ unsigned short f2bf(float f) { return (unsigned short)(cvt_pk_bf16(f, 0.f) & 0xffffu); }
__device__ __forceinline__ float wave_sum(float v) {
#pragma unroll
    for (int o = 1; o < 64; o <<= 1) v += __shfl_xor(v, o);
    return v;
}
__device__ __forceinline__ float fexp(float x) { return __builtin_amdgcn_exp2f(x * 1.4426950408889634f); }
__device__ __forceinline__ int opaque(int x) { asm volatile("" : "+v"(x)); return x; }
#define LDS_WAIT() asm volatile("s_waitcnt lgkmcnt(0)" ::: "memory")
#define SBAR() __builtin_amdgcn_sched_barrier(0)

#define XB_TMO      128
#define XB_XCNT(j)  (256  + 64 * (j))
#define XB_XSUB(j)  (1280 + 64 * (j))
#define XB_XGEN(j)  (2304 + 64 * (j))
#define XB_TOP      3328
#define XB_TOPGEN   3392
#define XCD_BAR_WORDS 3456
#define XB_SPIN_CAP (1u << 20)

__device__ __forceinline__ unsigned xb_ld(unsigned* p)              { return __hip_atomic_load(p, __ATOMIC_RELAXED, __HIP_MEMORY_SCOPE_AGENT); }
__device__ __forceinline__ unsigned xb_add(unsigned* p, unsigned v) { return __hip_atomic_fetch_add(p, v, __ATOMIC_RELAXED, __HIP_MEMORY_SCOPE_AGENT); }
__device__ __forceinline__ unsigned xb_xcc_id() { return (unsigned)__builtin_amdgcn_s_getreg((3 << 11) | 20) & 0xFu; }
#define XB_SPIN(cond, bar) do { unsigned _sp = 0; while (cond) { __builtin_amdgcn_s_sleep(1); \
    if ((++_sp & 255u) == 0u) { if (xb_ld(&(bar)[XB_TMO])) break; if (_sp > XB_SPIN_CAP) { atomicAdd(&(bar)[XB_TMO], 1u); break; } } } } while (0)

struct XcdBarrier { unsigned* bar; unsigned x; volatile LAS unsigned* st; };

__device__ __forceinline__ XcdBarrier xcd_barrier_post(unsigned* bar, volatile LAS unsigned* st) {
    XcdBarrier b; b.bar = bar; b.x = xb_xcc_id(); b.st = st;
    if (threadIdx.x == 0) (void)xb_add(&bar[XB_XCNT(b.x)], 1u);
    return b;
}
__device__ __forceinline__ void xcd_barrier_complete(unsigned* bar, unsigned x, unsigned& nloc, unsigned& nx) {
    const unsigned G = gridDim.x * gridDim.y * gridDim.z;
    unsigned sum, cnt, mine, sp = 0u;
    for (;;) {
        sum = 0u; cnt = 0u; mine = 0u;
#pragma unroll
        for (unsigned j = 0; j < 16; ++j) { const unsigned c = xb_ld(&bar[XB_XCNT(j)]); sum += c; cnt += (c > 0u) ? 1u : 0u; mine = (j == x) ? c : mine; }
        if (sum == G) break;
        __builtin_amdgcn_s_sleep(1);
        if ((++sp & 255u) == 0u) { if (xb_ld(&bar[XB_TMO])) break; if (sp > XB_SPIN_CAP) { atomicAdd(&bar[XB_TMO], 1u); break; } }
    }
    nloc = mine > 0u ? mine : 1u; nx = cnt > 0u ? cnt : 1u;
}
__device__ __forceinline__ void xcd_barrier(const XcdBarrier& b) {
    asm volatile("s_waitcnt vmcnt(0)" ::: "memory");
    __syncthreads();
    if (threadIdx.x == 0) {
        unsigned* bar = b.bar;
        __builtin_amdgcn_s_waitcnt(0);
        unsigned nloc = b.st[0], nx = b.st[1];
        if (nloc == 0u) { xcd_barrier_complete(bar, b.x, nloc, nx); b.st[0] = nloc; b.st[1] = nx; }
        const unsigned old = xb_add(&bar[XB_XSUB(b.x)], 1u);
        const unsigned gen = old / nloc;
        if (old + 1u == (gen + 1u) * nloc) {
            __builtin_amdgcn_fence(__ATOMIC_RELEASE, "agent");
            asm volatile("s_waitcnt vmcnt(0)" ::: "memory");
            const unsigned og = xb_add(&bar[XB_TOP], 1u);
            const unsigned tg = og / nx;
            if (og + 1u == (tg + 1u) * nx) xb_add(&bar[XB_TOPGEN], 1u);
            else XB_SPIN(xb_ld(&bar[XB_TOPGEN]) == tg, bar);
            __builtin_amdgcn_fence(__ATOMIC_ACQUIRE, "agent");
            xb_add(&bar[XB_XGEN(b.x)], 1u);
            asm volatile("s_waitcnt vmcnt(0)" ::: "memory");
        } else {
            XB_SPIN(xb_ld(&bar[XB_XGEN(b.x)]) == gen, bar);
            __builtin_amdgcn_fence(__ATOMIC_ACQUIRE, "agent");
            asm volatile("s_waitcnt vmcnt(0)" ::: "memory");
        }
    }
    __syncthreads();
}

namespace pg8 {
constexpr int BM = 256, BK = 64, HALF = 128, HTB = HALF * BK * 2, STAGE_BYTES = 8 * HTB, NXCD = 8, WGM = 8;
__device__ __forceinline__ int lds_byte(int r, int c) { const int st = (r >> 4) * 2 + (c >> 5), rr = r & 15, cc = c & 31, ob = rr * 64 + cc * 2; return st * 1024 + (ob ^ (((ob >> 9) & 1) << 5)); }
__device__ __forceinline__ void stage_rc(int b, int& R_, int& C) { const int st = b / 1024, sb = b % 1024, swz = sb ^ (((sb >> 9) & 1) << 5); R_ = (st >> 1) * 16 + swz / 64; C = (st & 1) * 32 + (swz % 64) / 2; }
__device__ __forceinline__ int perm32(int rho) { const int n = rho >> 4, i = rho & 15; return 8 * (i >> 2) + 4 * n + (i & 3); }
struct Unit { int pm, pn; };
struct Gemm { const bf16_t* A; const bf16_t* Bt; int M, N, K, lda, ldb; };
struct StaticOrder {
    int nM, nN, nwg, G, c;
    __device__ void init(int M, int N, int G_, int c_) { nM = M / BM; nN = N / BM; nwg = nM * nN; G = G_; c = c_; }
    __device__ bool next(int i, Unit& u) const {
        const long L = (long)i * G + c; if (L >= nwg) return false;
        int wgid = (int)L; { const int q = nwg / NXCD, r = nwg % NXCD, xcd = wgid % NXCD, off = wgid / NXCD; wgid = (xcd < r ? xcd * (q + 1) : r * (q + 1) + (xcd - r) * q) + off; }
        const int nig = WGM * nN, gid = wgid / nig, fm = gid * WGM, gsz = (nM - fm) < WGM ? (nM - fm) : WGM;
        u.pm = fm + ((wgid % nig) % gsz); u.pn = (wgid % nig) / gsz; return true;
    }
};
struct EpiBf16 {
    static constexpr bool PERM = true;
    bf16_t* O; int ldc;
    __device__ __forceinline__ void operator()(const f32x4 (&acc)[2][2][4][2], const Unit& u, int wr, int wc, int fr, int fq) const {
        const int row0 = u.pm * BM + wr * 64 + fr, col0 = u.pn * BM + wc * 32 + 8 * fq;
#pragma unroll
        for (int ai = 0; ai < 2; ++ai)
#pragma unroll
            for (int m = 0; m < 4; ++m) { bf16_t* rowp = O + (size_t)(row0 + ai * HALF + m * 16) * ldc + col0;
#pragma unroll
                for (int bj = 0; bj < 2; ++bj) { const f32x4 v0 = acc[ai][bj][m][0], v1 = acc[ai][bj][m][1];
                    u32x4 w; w.x = cvt_pk_bf16(v0[0], v0[1]); w.y = cvt_pk_bf16(v0[2], v0[3]); w.z = cvt_pk_bf16(v1[0], v1[1]); w.w = cvt_pk_bf16(v1[2], v1[3]);
                    *(u32x4*)(rowp + bj * HALF) = w; } }
    }
};
__device__ __forceinline__ float silu_mul(float g, float u) { return g * u * __builtin_amdgcn_rcpf(1.0f + __builtin_amdgcn_exp2f(-g * 1.4426950408889634f)); }
struct EpiSwiGLU {
    static constexpr bool PERM = true;
    bf16_t* O; int ldc;
    __device__ __forceinline__ void operator()(const f32x4 (&acc)[2][2][4][2], const Unit& u, int wr, int wc, int fr, int fq) const {
        const int row0 = u.pm * BM + wr * 64 + fr, col0 = u.pn * HALF + wc * 32 + 8 * fq;
#pragma unroll
        for (int ai = 0; ai < 2; ++ai)
#pragma unroll
            for (int m = 0; m < 4; ++m) { bf16_t* rowp = O + (size_t)(row0 + ai * HALF + m * 16) * ldc + col0;
                const f32x4 g0 = acc[ai][0][m][0], g1 = acc[ai][0][m][1], u0 = acc[ai][1][m][0], u1 = acc[ai][1][m][1];
                u32x4 w; w.x = cvt_pk_bf16(silu_mul(g0[0], u0[0]), silu_mul(g0[1], u0[1])); w.y = cvt_pk_bf16(silu_mul(g0[2], u0[2]), silu_mul(g0[3], u0[3]));
                w.z = cvt_pk_bf16(silu_mul(g1[0], u1[0]), silu_mul(g1[1], u1[1])); w.w = cvt_pk_bf16(silu_mul(g1[2], u1[2]), silu_mul(g1[3], u1[3]));
                *(u32x4*)rowp = w; }
    }
};

template <class Epi>
__device__ __forceinline__ void gemm_phase(LAS unsigned char* lds, const Gemm g, const StaticOrder& S, const Epi& E) {
    const int tid = opaque(threadIdx.x), wid = __builtin_amdgcn_readfirstlane(tid >> 6), lane = tid & 63, wr = wid >> 2, wc = wid & 3, fr = lane & 15, fq = lane >> 4;
    const int K = g.K, nt = K / BK;
    unsigned voffA[2], voffB[2];
#pragma unroll
    for (int i = 0; i < 2; ++i) { int R_, C; stage_rc(tid * 16 + i * 8192, R_, C); const int Rb = Epi::PERM ? ((R_ & ~31) + perm32(R_ & 31)) : R_;
        voffA[i] = (unsigned)(R_ * g.lda + C) * 2u; voffB[i] = (unsigned)(Rb * g.ldb + C) * 2u; }
    const size_t kstep = (size_t)(BK * 2);
    const size_t hstepA = (size_t)HALF * g.lda * 2, hstepB = (size_t)HALF * g.ldb * 2;
    const size_t tstepA = 2 * hstepA, tstepB = 2 * hstepB;
    const unsigned ldsw = (unsigned)wid * 1024u;
    const int aoff = lds_byte(wr * 64 + fr, fq * 8), boff = lds_byte(wc * 32 + fr, fq * 8);
#define PG8_SA(b, h) (((b) * 2 + (h)) * HTB)
#define PG8_SB(b, h) ((4 + (b) * 2 + (h)) * HTB)
#define PG8_STAGE(bufoff, gbase, voff) do { _Pragma("unroll") for (int _i = 0; _i < 2; ++_i) \
        __builtin_amdgcn_global_load_lds((const unsigned*)((const char*)(gbase) + (voff)[_i]), (LAS unsigned*)(lds + (bufoff) + ldsw + _i * 8192), 16, 0, 0); } while (0)
#define PG8_LDA(dst, b, h) do { _Pragma("unroll") for (int m = 0; m < 4; ++m) _Pragma("unroll") for (int k = 0; k < 2; ++k) dst[m][k] = *(const LAS bf16x8*)(lds + PG8_SA(b, h) + aoff + m * 2048 + k * 1024); } while (0)
#define PG8_LDB(dst, b, h) do { _Pragma("unroll") for (int n = 0; n < 2; ++n) _Pragma("unroll") for (int k = 0; k < 2; ++k) dst[n][k] = *(const LAS bf16x8*)(lds + PG8_SB(b, h) + boff + n * 2048 + k * 1024); } while (0)
#define PG8_MMA(ai, bj, At, Bt) do { __builtin_amdgcn_s_setprio(1); _Pragma("unroll") for (int m = 0; m < 4; ++m) _Pragma("unroll") for (int n = 0; n < 2; ++n) _Pragma("unroll") for (int k = 0; k < 2; ++k) \
        acc[ai][bj][m][n] = __builtin_amdgcn_mfma_f32_16x16x32_bf16(Bt[n][k], At[m][k], acc[ai][bj][m][n], 0, 0, 0); __builtin_amdgcn_s_setprio(0); } while (0)
#define PG8_WAIT_V(n) asm volatile("s_waitcnt vmcnt(" #n ")" ::: "memory")
#define PG8_WAIT_L(n) asm volatile("s_waitcnt lgkmcnt(" #n ")" ::: "memory")
#define PG8_BAR __builtin_amdgcn_s_barrier()
#define PG8_SCHED __builtin_amdgcn_sched_barrier(0)
    Unit cur, nxt; int ui = 0;
    if (!S.next(0, cur)) return;
    f32x4 acc[2][2][4][2];
#pragma unroll
    for (int a = 0; a < 2; ++a)
#pragma unroll
        for (int b = 0; b < 2; ++b)
#pragma unroll
            for (int m = 0; m < 4; ++m)
#pragma unroll
                for (int n = 0; n < 2; ++n) acc[a][b][m][n] = (f32x4){0.f, 0.f, 0.f, 0.f};
    bf16x8 At[4][2], B0[2][2], B1[2][2];
    const char* cA = (const char*)g.A + (size_t)cur.pm * tstepA; const char* cB = (const char*)g.Bt + (size_t)cur.pn * tstepB;
    PG8_STAGE(PG8_SB(0, 0), cB, voffB); PG8_STAGE(PG8_SA(0, 0), cA, voffA); PG8_STAGE(PG8_SB(0, 1), cB + hstepB, voffB); PG8_STAGE(PG8_SA(0, 1), cA + hstepA, voffA);
    if (wr == 1) PG8_BAR;
    PG8_WAIT_V(4); PG8_BAR;
    PG8_STAGE(PG8_SB(1, 0), cB + kstep, voffB); PG8_STAGE(PG8_SA(1, 0), cA + kstep, voffA); PG8_STAGE(PG8_SB(1, 1), cB + hstepB + kstep, voffB);
    PG8_WAIT_V(6); PG8_BAR;
    for (;;) {
        const bool has_next = S.next(ui + 1, nxt);
        const char* nA = has_next ? (const char*)g.A + (size_t)nxt.pm * tstepA : cA; const char* nB = has_next ? (const char*)g.Bt + (size_t)nxt.pn * tstepB : cB;
        for (int t = 0; t < nt; t += 2) {
            const bool last = (t == nt - 2);
            const char* a1 = cA + (size_t)(t + 1) * kstep;
            const char* a2 = last ? nA : cA + (size_t)(t + 2) * kstep; const char* b2 = last ? nB : cB + (size_t)(t + 2) * kstep;
            const char* a3 = a2 + kstep; const char* b3 = b2 + kstep;
            PG8_LDB(B0, 0, 0); PG8_SCHED; PG8_LDA(At, 0, 0); PG8_STAGE(PG8_SA(1, 1), a1 + hstepA, voffA);
            PG8_WAIT_L(8); PG8_BAR; PG8_WAIT_L(0); PG8_MMA(0, 0, At, B0); PG8_BAR; PG8_SCHED;
            PG8_LDB(B1, 0, 1); PG8_STAGE(PG8_SB(0, 0), b2, voffB);
            PG8_BAR; PG8_WAIT_L(0); PG8_MMA(0, 1, At, B1); PG8_BAR;
            PG8_LDA(At, 0, 1); PG8_STAGE(PG8_SA(0, 0), a2, voffA);
            PG8_BAR; PG8_WAIT_L(0); PG8_MMA(1, 0, At, B0); PG8_BAR; PG8_SCHED;
            PG8_STAGE(PG8_SB(0, 1), b2 + hstepB, voffB);
            PG8_WAIT_V(6); PG8_BAR; PG8_MMA(1, 1, At, B1); PG8_BAR;
            PG8_LDB(B0, 1, 0); PG8_SCHED; PG8_LDA(At, 1, 0); PG8_STAGE(PG8_SA(0, 1), a2 + hstepA, voffA);
            PG8_WAIT_L(8); PG8_BAR; PG8_WAIT_L(0); PG8_MMA(0, 0, At, B0); PG8_BAR; PG8_SCHED;
            PG8_LDB(B1, 1, 1); PG8_STAGE(PG8_SB(1, 0), b3, voffB);
            PG8_BAR; PG8_WAIT_L(0); PG8_MMA(0, 1, At, B1); PG8_BAR;
            PG8_LDA(At, 1, 1); PG8_STAGE(PG8_SA(1, 0), a3, voffA);
            PG8_BAR; PG8_WAIT_L(0); PG8_MMA(1, 0, At, B0); PG8_BAR; PG8_SCHED;
            PG8_STAGE(PG8_SB(1, 1), b3 + hstepB, voffB);
            PG8_WAIT_V(6); PG8_BAR; PG8_MMA(1, 1, At, B1); PG8_BAR;
        }
        E(acc, cur, wr, wc, fr, fq);
        if (!has_next) break;
#pragma unroll
        for (int a = 0; a < 2; ++a)
#pragma unroll
            for (int b = 0; b < 2; ++b)
#pragma unroll
                for (int m = 0; m < 4; ++m)
#pragma unroll
                    for (int n = 0; n < 2; ++n) acc[a][b][m][n] = (f32x4){0.f, 0.f, 0.f, 0.f};
        cur = nxt; cA = nA; cB = nB; ++ui;
    }
    PG8_WAIT_V(0);
    if (wr == 0) PG8_BAR;
    PG8_BAR;
#undef PG8_SA
#undef PG8_SB
#undef PG8_STAGE
#undef PG8_LDA
#undef PG8_LDB
#undef PG8_MMA
#undef PG8_WAIT_V
#undef PG8_WAIT_L
#undef PG8_BAR
#undef PG8_SCHED
}
}

template <int MAP> __device__ __forceinline__ int map_col(int n) {
    if (MAP == 0) return n;
    if (MAP == 1) return n < 6144 ? n : (n < 8256 ? n + 8 : (n < 8264 ? n - 2112 : -1));
    const int T = n >> 8, w = n & 255; return w < 128 ? 128 * T + w : DFF + 128 * T + (w - 128);
}
template <int MAP> __device__ __forceinline__ void cvt_matrix(const float* W, int K, int Nsrc, bf16_t* WT, int Ndst, LAS float* scr, int lane, int gw, int NGW) {
    const int nblk = Ndst / 32, nitems = (K / 64) * nblk;
    for (int item = gw; item < nitems; item += NGW) {
        const int kb = item / nblk, nb = item % nblk, k0 = 64 * kb, n0 = 32 * nb;
        const int src = map_col<MAP>(n0 + (lane & 31));
        const float* wp = W + (size_t)(k0 + (lane >> 5)) * Nsrc + (src >= 0 ? src : 0);
#pragma unroll 8
        for (int i = 0; i < 32; ++i) { const int kk = 2 * i + (lane >> 5); float v = wp[(size_t)(2 * i) * Nsrc]; if (src < 0) v = 0.f; scr[kk * 33 + (lane & 31)] = v; }
        LDS_WAIT();
        const int c = lane & 7;
#pragma unroll
        for (int j = 0; j < 4; ++j) { const int n = (lane >> 3) + 8 * j; const LAS float* s = scr + (8 * c) * 33 + n;
            u32x4 o; o.x = cvt_pk_bf16(s[0 * 33], s[1 * 33]); o.y = cvt_pk_bf16(s[2 * 33], s[3 * 33]); o.z = cvt_pk_bf16(s[4 * 33], s[5 * 33]); o.w = cvt_pk_bf16(s[6 * 33], s[7 * 33]);
            *(u32x4*)(WT + (size_t)(n0 + n) * K + k0 + 8 * c) = o; }
        LDS_WAIT();
    }
}

struct Ptrs {
    const float* in[17]; float* out; unsigned char* ws;
};
__device__ __forceinline__ bf16_t* w_ptr(unsigned char* ws, int l, int which) {
    size_t off = WS_W + (size_t)l * SZ_WL;
    if (which > 0) off += SZ_WIN; if (which > 1) off += SZ_WUQ; if (which > 2) off += SZ_WUKV; if (which > 3) off += SZ_WOUT; if (which > 4) off += SZ_WGU;
    return (bf16_t*)(ws + off);
}

__device__ __forceinline__ void p_prologue(const Ptrs& P, LAS unsigned char* lds, int gw, int NGW, int wave, int lane) {
    lane = opaque(lane); gw = opaque(gw);
    LAS float* scr = (LAS float*)(lds + wave * 8704);
    for (int l = 0; l < 2; ++l) {
        cvt_matrix<1>(P.in[3] + (size_t)l * DM * NIN_SRC, DM, NIN_SRC, w_ptr(P.ws, l, 0), NIN, scr, lane, gw, NGW);
        cvt_matrix<0>(P.in[8] + (size_t)l * QL * NQF, QL, NQF, w_ptr(P.ws, l, 1), NQF, scr, lane, gw, NGW);
        cvt_matrix<0>(P.in[10] + (size_t)l * KVL * NKVF, KVL, NKVF, w_ptr(P.ws, l, 2), NKVF, scr, lane, gw, NGW);
        cvt_matrix<0>(P.in[11] + (size_t)l * DM * DM, DM, DM, w_ptr(P.ws, l, 3), DM, scr, lane, gw, NGW);
        cvt_matrix<2>(P.in[14] + (size_t)l * DM * NGU, DM, NGU, w_ptr(P.ws, l, 4), NGU, scr, lane, gw, NGW);
        cvt_matrix<0>(P.in[15] + (size_t)l * DFF * DM, DFF, DM, w_ptr(P.ws, l, 5), DM, scr, lane, gw, NGW);
    }
    float* cosT = (float*)(P.ws + WS_COS); float* sinT = (float*)(P.ws + WS_SIN);
    for (int idx = gw * 64 + lane; idx < R * 32; idx += NGW * 64) {
        const int r = idx >> 5, i = idx & 31; const int pos = r >= RFIRST ? r - RFIRST : 0;
        const float invf = (float)pow(10000.0, -(double)i / 32.0);
        const float ang = (float)pos * invf;
        cosT[idx] = (float)cos((double)ang); sinT[idx] = (float)sin((double)ang);
    }
    float* hres = (float*)(P.ws + WS_HRES); bf16_t* u = (bf16_t*)(P.ws + WS_U);
    const float* g0 = P.in[2];
    for (int r = gw; r < R; r += NGW) {
        f32x4* hr = (f32x4*)(hres + (size_t)r * DM); u32x2* ur = (u32x2*)(u + (size_t)r * DM);
        if (r < RFIRST) {
#pragma unroll
            for (int j = 0; j < 16; ++j) { hr[64 * j + lane] = (f32x4){0.f, 0.f, 0.f, 0.f}; ur[64 * j + lane] = (u32x2){0u, 0u}; }
            continue;
        }
        const f32x4* src = (const f32x4*)(r < 256 ? P.in[1] + (size_t)(r - RFIRST) * DM : P.in[0] + (size_t)(r - 256) * DM);
        f32x4 v[16]; float ss = 0.f;
#pragma unroll
        for (int j = 0; j < 16; ++j) { v[j] = src[64 * j + lane]; ss += (v[j][0] * v[j][0] + v[j][1] * v[j][1]) + (v[j][2] * v[j][2] + v[j][3] * v[j][3]); }
        const float rs = 1.0f / sqrtf(wave_sum(ss) * (1.0f / DM) + EPS);
#pragma unroll
        for (int j = 0; j < 16; ++j) { hr[64 * j + lane] = v[j]; const f32x4 g = ((const f32x4*)g0)[64 * j + lane];
            ur[64 * j + lane] = (u32x2){cvt_pk_bf16(v[j][0] * rs * g[0], v[j][1] * rs * g[1]), cvt_pk_bf16(v[j][2] * rs * g[2], v[j][3] * rs * g[3])}; }
    }
}

__device__ __forceinline__ void p_resnorm(const bf16_t* y, float* hres, const float* gpost, const float* gnext, bf16_t* u, float* out, int gw, int NGW, int lane) {
    lane = opaque(lane); gw = opaque(gw);
    for (int r = gw; r < R; r += NGW) {
        if (r < RFIRST) continue;
        f32x4* hr = (f32x4*)(hres + (size_t)r * DM); const u32x2* yr = (const u32x2*)(y + (size_t)r * DM);
        f32x4 v[16]; float ss = 0.f;
#pragma unroll
        for (int j = 0; j < 16; ++j) { const u32x2 w = yr[64 * j + lane]; v[j] = (f32x4){bflo(w.x), bfhi(w.x), bflo(w.y), bfhi(w.y)};
            ss += (v[j][0] * v[j][0] + v[j][1] * v[j][1]) + (v[j][2] * v[j][2] + v[j][3] * v[j][3]); }
        const float rs = 1.0f / sqrtf(wave_sum(ss) * (1.0f / DM) + EPS);
        float ss2 = 0.f;
#pragma unroll
        for (int j = 0; j < 16; ++j) { const f32x4 g = ((const f32x4*)gpost)[64 * j + lane]; const f32x4 x = hr[64 * j + lane];
            v[j] = x + v[j] * rs * g; ss2 += (v[j][0] * v[j][0] + v[j][1] * v[j][1]) + (v[j][2] * v[j][2] + v[j][3] * v[j][3]); }
        if (out) {
            if (r >= 256) { f32x4* orow = (f32x4*)(out + (size_t)(r - 256) * DM);
#pragma unroll
                for (int j = 0; j < 16; ++j) orow[64 * j + lane] = v[j]; }
        } else {
            const float rs2 = 1.0f / sqrtf(wave_sum(ss2) * (1.0f / DM) + EPS);
            u32x2* ur = (u32x2*)(u + (size_t)r * DM);
#pragma unroll
            for (int j = 0; j < 16; ++j) { hr[64 * j + lane] = v[j]; const f32x4 g = ((const f32x4*)gnext)[64 * j + lane];
                ur[64 * j + lane] = (u32x2){cvt_pk_bf16(v[j][0] * rs2 * g[0], v[j][1] * rs2 * g[1]), cvt_pk_bf16(v[j][2] * rs2 * g[2], v[j][3] * rs2 * g[3])}; }
        }
    }
}

__device__ __forceinline__ void unpack8(const u32x4 w, float (&f)[8]) {
    f[0] = bflo(w.x); f[1] = bfhi(w.x); f[2] = bflo(w.y); f[3] = bfhi(w.y); f[4] = bflo(w.z); f[5] = bfhi(w.z); f[6] = bflo(w.w); f[7] = bfhi(w.w);
}
__device__ __forceinline__ u32x4 pack8f(const float (&f)[8]) { return (u32x4){cvt_pk_bf16(f[0], f[1]), cvt_pk_bf16(f[2], f[3]), cvt_pk_bf16(f[4], f[5]), cvt_pk_bf16(f[6], f[7])}; }

__device__ __forceinline__ void p_prep(const bf16_t* z, const float* convw, const float* bg, const float* gcq, const float* gckv, const float* cosT, const float* sinT,
                                       bf16_t* qc, bf16_t* kc, float* li, float* lf, bf16_t* cqn, bf16_t* ckvn, bf16_t* krr, int gw, int NGW, int lane) {
    lane = opaque(lane); gw = opaque(gw);
    for (int r = gw; r < R; r += NGW) {
        const bf16_t* zr = z + (size_t)r * NIN;
        if (r < RFIRST) {
            const unsigned zz = (unsigned)opaque(0); const u32x4 zero4 = (u32x4){zz, zz, zz, zz};
#pragma unroll
            for (int j = 0; j < 2; ++j) { *(u32x4*)(qc + (size_t)r * 1024 + 8 * (64 * j + lane)) = zero4; *(u32x4*)(kc + (size_t)r * 1024 + 8 * (64 * j + lane)) = zero4; }
#pragma unroll
            for (int j = 0; j < 3; ++j) *(u32x4*)(cqn + (size_t)r * QL + 8 * (64 * j + lane)) = zero4;
            *(u32x4*)(ckvn + (size_t)r * KVL + 8 * lane) = zero4;
            if (lane < 8) *(u32x4*)(krr + (size_t)r * 64 + 8 * lane) = zero4;
            if (lane < 4) { li[(size_t)r * 4 + lane] = -__builtin_inff(); lf[(size_t)r * 4 + lane] = 0.f; }
            continue;
        }
#pragma unroll
        for (int j = 0; j < 4; ++j) {
            const int c0 = 8 * (64 * j + lane);
            float a[8];
#pragma unroll
            for (int e = 0; e < 8; ++e) a[e] = 0.f;
#pragma unroll
            for (int tap = 0; tap < 4; ++tap) {
                const u32x4 xw = *(const u32x4*)(zr + (ptrdiff_t)(tap - 3) * NIN + c0); float x[8]; unpack8(xw, x);
                const f32x4 w0 = *(const f32x4*)(convw + tap * 2048 + c0), w1 = *(const f32x4*)(convw + tap * 2048 + c0 + 4);
                a[0] += w0[0] * x[0]; a[1] += w0[1] * x[1]; a[2] += w0[2] * x[2]; a[3] += w0[3] * x[3];
                a[4] += w1[0] * x[4]; a[5] += w1[1] * x[5]; a[6] += w1[2] * x[6]; a[7] += w1[3] * x[7];
            }
            const float sc = (c0 < 1024) ? 0.0625f : 1.0f;
#pragma unroll
            for (int e = 0; e < 8; ++e) a[e] = a[e] / (1.0f + __expf(-a[e])) * sc;
            bf16_t* dst = (c0 < 1024) ? qc + (size_t)r * 1024 + c0 : kc + (size_t)r * 1024 + (c0 - 1024);
            *(u32x4*)dst = pack8f(a);
        }
        if (lane < 8) { const float val = bf2f(zr[ZGI + lane]) + bg[lane];
            if (lane < 4) li[(size_t)r * 4 + lane] = val;
            else lf[(size_t)r * 4 + (lane - 4)] = fminf(val, 0.f) - log1pf(__expf(-fabsf(val))); }
        { float x[3][8]; float ss = 0.f;
#pragma unroll
          for (int j = 0; j < 3; ++j) { unpack8(*(const u32x4*)(zr + ZCQ + 8 * (64 * j + lane)), x[j]);
#pragma unroll
              for (int e = 0; e < 8; ++e) ss += x[j][e] * x[j][e]; }
          const float rs = 1.0f / sqrtf(wave_sum(ss) * (1.0f / QL) + EPS);
#pragma unroll
          for (int j = 0; j < 3; ++j) { const int c0 = 8 * (64 * j + lane); const f32x4 g0 = *(const f32x4*)(gcq + c0), g1 = *(const f32x4*)(gcq + c0 + 4);
              float o[8] = {x[j][0] * rs * g0[0], x[j][1] * rs * g0[1], x[j][2] * rs * g0[2], x[j][3] * rs * g0[3], x[j][4] * rs * g1[0], x[j][5] * rs * g1[1], x[j][6] * rs * g1[2], x[j][7] * rs * g1[3]};
              *(u32x4*)(cqn + (size_t)r * QL + c0) = pack8f(o); } }
        { float x[8]; unpack8(*(const u32x4*)(zr + ZCKV + 8 * lane), x); float ss = 0.f;
#pragma unroll
          for (int e = 0; e < 8; ++e) ss += x[e] * x[e];
          const float rs = 1.0f / sqrtf(wave_sum(ss) * (1.0f / KVL) + EPS);
          const f32x4 g0 = *(const f32x4*)(gckv + 8 * lane), g1 = *(const f32x4*)(gckv + 8 * lane + 4);
          float o[8] = {x[0] * rs * g0[0], x[1] * rs * g0[1], x[2] * rs * g0[2], x[3] * rs * g0[3], x[4] * rs * g1[0], x[5] * rs * g1[1], x[6] * rs * g1[2], x[7] * rs * g1[3]};
          *(u32x4*)(ckvn + (size_t)r * KVL + 8 * lane) = pack8f(o); }
        if (lane < 32) { const float x1 = bf2f(zr[ZKR + lane]), x2 = bf2f(zr[ZKR + 32 + lane]); const float c = cosT[(size_t)r * 32 + lane], s = sinT[(size_t)r * 32 + lane];
            krr[(size_t)r * 64 + lane] = f2bf(x1 * c - x2 * s); krr[(size_t)r * 64 + 32 + lane] = f2bf(x1 * s + x2 * c); }
    }
}

__device__ __forceinline__ void p_hcat(const float* hm, const bf16_t* z, const float* gmn, bf16_t* hcat, int gw, int NGW, int lane) {
    lane = opaque(lane); gw = opaque(gw);
    for (int r = gw; r < R; r += NGW) {
        if (r < RFIRST) {
            const unsigned zz = (unsigned)opaque(0); const u32x4 zero4 = (u32x4){zz, zz, zz, zz};
#pragma unroll
            for (int j = 0; j < 8; ++j) *(u32x4*)(hcat + (size_t)r * DM + 8 * (64 * j + lane)) = zero4;
            continue;
        }
#pragma unroll
        for (int h = 0; h < 4; ++h) {
            const int c0 = h * 512 + 8 * lane;
            const f32x4 a = *(const f32x4*)(hm + (size_t)r * 2048 + c0), b = *(const f32x4*)(hm + (size_t)r * 2048 + c0 + 4);
            const float ss = (a[0] * a[0] + a[1] * a[1]) + (a[2] * a[2] + a[3] * a[3]) + (b[0] * b[0] + b[1] * b[1]) + (b[2] * b[2] + b[3] * b[3]);
            const float rs = 1.0f / sqrtf(wave_sum(ss) * (1.0f / 512.0f) + EPS);
            float o[8]; unpack8(*(const u32x4*)(z + (size_t)r * NIN + ZO + c0), o);
            const f32x4 g0 = *(const f32x4*)(gmn + c0), g1 = *(const f32x4*)(gmn + c0 + 4);
            const float hv[8] = {a[0], a[1], a[2], a[3], b[0], b[1], b[2], b[3]}; const float gv[8] = {g0[0], g0[1], g0[2], g0[3], g1[0], g1[1], g1[2], g1[3]};
            float res[8];
#pragma unroll
            for (int e = 0; e < 8; ++e) res[e] = hv[e] * rs * gv[e] / (1.0f + __expf(-o[e]));
            *(u32x4*)(hcat + (size_t)r * DM + c0) = pack8f(res);
        }
    }
}

namespace att {
constexpr float SCALE = 0.07216878364870323f;
constexpr float THR = 8.f;
constexpr int KVBLK = 64, SHM_V = 64 * 128 * 2, SHM_K = 64 * 192 * 2;
constexpr int OFF_V = 0, OFF_K = 2 * SHM_V, OFF_WS = OFF_K + 2 * SHM_K;
__device__ __forceinline__ int v_st(int k, int c) { const int kk = (k & ~0xC) | ((k & 4) << 1) | ((k & 8) >> 1); return ((kk >> 3) * 4 + (c >> 5)) * 512 + ((kk & 7) * 32 + (c & 31)) * 2; }
__device__ __forceinline__ int v_rd_base(int lane) { return ((lane & 3) << 3) | (((lane >> 2) & 3) << 6) | (((lane >> 4) & 1) << 5) | (((lane >> 5) & 1) << 8); }
constexpr int v_rd_off(int d0, int ks, int half) { return d0 * 512 + ks * 4096 + half * 2048; }
__device__ __forceinline__ int crow(int r, int hi) { return (r & 3) + 8 * (r >> 2) + 4 * hi; }
__device__ __forceinline__ int k_off(int row, int ch) { return row * 384 + (((ch & ~7) | ((ch & 7) ^ ((row >> 1) & 7))) << 4); }

__device__ __forceinline__ void partialSM(f32x16& p0, f32x16& p1, float& m_reg, float& mn, float& alpha) {
    float pmax = p0[0];
#pragma unroll
    for (int r = 1; r < 16; ++r) pmax = fmaxf(pmax, p0[r]);
#pragma unroll
    for (int r = 0; r < 16; ++r) pmax = fmaxf(pmax, p1[r]);
    { auto rr = __builtin_amdgcn_permlane32_swap(__float_as_uint(pmax), __float_as_uint(pmax), false, false);
      pmax = fmaxf(__uint_as_float(rr[0]), __uint_as_float(rr[1])); }
    constexpr float C2 = 1.4426950408889634f * SCALE;
    if (__builtin_expect(__all((pmax - m_reg) * SCALE <= THR), 1)) { mn = m_reg; alpha = 1.f; }
    else { mn = fmaxf(m_reg, pmax); alpha = __builtin_amdgcn_exp2f((m_reg - mn) * C2); m_reg = mn; }
    const float mnL = -mn * C2;
#pragma unroll
    for (int r = 0; r < 16; ++r) p0[r] = fmaf(p0[r], C2, mnL);
#pragma unroll
    for (int r = 0; r < 16; ++r) p1[r] = fmaf(p1[r], C2, mnL);
#pragma unroll
    for (int r = 0; r < 16; ++r) p0[r] = __builtin_amdgcn_exp2f(p0[r]);
}
__device__ __forceinline__ void finishSM(f32x16& p0, f32x16& p1, float alpha, float& l_reg, bf16x8& pa0, bf16x8& pa1, bf16x8& pa2, bf16x8& pa3) {
#pragma unroll
    for (int r = 0; r < 16; ++r) p1[r] = __builtin_amdgcn_exp2f(p1[r]);
    float ps = 0;
#pragma unroll
    for (int r = 0; r < 16; ++r) ps += p0[r];
#pragma unroll
    for (int r = 0; r < 16; ++r) ps += p1[r];
    { auto rr = __builtin_amdgcn_permlane32_swap(__float_as_uint(ps), __float_as_uint(ps), false, false);
      ps = __uint_as_float(rr[0]) + __uint_as_float(rr[1]); }
    l_reg = l_reg * alpha + ps;
#define PK4(P, B_, OUT) do { unsigned a0 = cvt_pk_bf16(P[B_+0], P[B_+1]), a1 = cvt_pk_bf16(P[B_+2], P[B_+3]);                          \
        unsigned b0 = cvt_pk_bf16(P[B_+4], P[B_+5]), b1 = cvt_pk_bf16(P[B_+6], P[B_+7]);                                             \
        auto r0 = __builtin_amdgcn_permlane32_swap(a0, b0, false, false); auto r1 = __builtin_amdgcn_permlane32_swap(a1, b1, false, false); \
        u32x4 w = {r0[0], r1[0], r0[1], r1[1]}; OUT = *reinterpret_cast<bf16x8*>(&w); } while (0)
    PK4(p0, 0, pa0); PK4(p0, 8, pa1); PK4(p1, 0, pa2); PK4(p1, 8, pa3);
#undef PK4
}
template <int KB>
__device__ __forceinline__ void qkt(f32x16& p0, f32x16& p1, LAS const char* K_lds, int r32, int hi, const bf16x8* qr) {
    p0 = f32x16{}; p1 = f32x16{};
    LAS const char* kb[4];
#pragma unroll
    for (int dd = 0; dd < 4; ++dd) kb[dd] = K_lds + KB * SHM_K + k_off(r32, dd * 2 + hi);
#pragma unroll
    for (int d0 = 0; d0 < 12; ++d0) { LAS const char* a = kb[d0 & 3] + (d0 >> 2) * 128;
        const bf16x8 b0 = *reinterpret_cast<LAS const bf16x8*>(a);
        const bf16x8 b1 = *reinterpret_cast<LAS const bf16x8*>(a + 32 * 384);
        p0 = __builtin_amdgcn_mfma_f32_32x32x16_bf16(b0, qr[d0], p0, 0, 0, 0);
        p1 = __builtin_amdgcn_mfma_f32_32x32x16_bf16(b1, qr[d0], p1, 0, 0, 0); }
}
template <int VB>
__device__ __forceinline__ void pv_tile(f32x16* o, unsigned vb0, bf16x8 pa0, bf16x8 pa1, bf16x8 pa2, bf16x8 pa3) {
#define TRRD(dst, off) asm volatile("ds_read_b64_tr_b16 %0, %1 offset:%2" : "=&v"(dst) : "v"(vb0), "i"(off) : "memory")
#define PV_D0(d0) do { s16x4 l0, l1, l2, l3, h0, h1, h2, h3; constexpr int b_ = VB * SHM_V + v_rd_off(d0, 0, 0); \
        TRRD(l0, b_); TRRD(h0, b_ + 2048); TRRD(l1, b_ + 4096); TRRD(h1, b_ + 6144); TRRD(l2, b_ + 8192); TRRD(h2, b_ + 10240); TRRD(l3, b_ + 12288); TRRD(h3, b_ + 14336); \
        asm volatile("s_waitcnt lgkmcnt(0)" ::: "memory"); SBAR();   \
        o[d0] = __builtin_amdgcn_mfma_f32_32x32x16_bf16(pa0, (bf16x8){l0[0], l0[1], l0[2], l0[3], h0[0], h0[1], h0[2], h0[3]}, o[d0], 0, 0, 0);   \
        o[d0] = __builtin_amdgcn_mfma_f32_32x32x16_bf16(pa1, (bf16x8){l1[0], l1[1], l1[2], l1[3], h1[0], h1[1], h1[2], h1[3]}, o[d0], 0, 0, 0);   \
        o[d0] = __builtin_amdgcn_mfma_f32_32x32x16_bf16(pa2, (bf16x8){l2[0], l2[1], l2[2], l2[3], h2[0], h2[1], h2[2], h2[3]}, o[d0], 0, 0, 0);   \
        o[d0] = __builtin_amdgcn_mfma_f32_32x32x16_bf16(pa3, (bf16x8){l3[0], l3[1], l3[2], l3[3], h3[0], h3[1], h3[2], h3[3]}, o[d0], 0, 0, 0); } while (0)
    PV_D0(0); PV_D0(1); PV_D0(2); PV_D0(3);
#undef PV_D0
#undef TRRD
}

__device__ __forceinline__ void attn_unit(LAS char* lds, int head, int qb, const bf16_t* qf, const bf16_t* kvf, const bf16_t* krr,
                                          const float* cosT, const float* sinT, bf16_t* hcat) {
    const int tid = opaque(threadIdx.x), wid = __builtin_amdgcn_readfirstlane(tid >> 6), lane = tid & 63, r32 = lane & 31, hi = lane >> 5;
    const int row_w0 = qb * 256 + wid * 32, qrow = row_w0 + r32;
    LAS char* V_lds = lds + OFF_V; LAS char* K_lds = lds + OFF_K;
    LAS float* wsf = (LAS float*)(lds + OFF_WS) + wid * 64; LAS float* li_l = wsf; LAS float* al_l = wsf + 32;
    bf16x8 qr[12];
    { const bf16_t* qp = qf + (size_t)qrow * NQF + head * 192 + hi * 8;
#pragma unroll
      for (int d0 = 0; d0 < 12; ++d0) qr[d0] = *(const bf16x8*)(qp + d0 * 16);
#pragma unroll
      for (int pp = 0; pp < 2; ++pp) {
          const int i0 = pp * 16 + hi * 8;
          const f32x4 c0 = *(const f32x4*)(cosT + (size_t)qrow * 32 + i0), c1 = *(const f32x4*)(cosT + (size_t)qrow * 32 + i0 + 4);
          const f32x4 s0 = *(const f32x4*)(sinT + (size_t)qrow * 32 + i0), s1 = *(const f32x4*)(sinT + (size_t)qrow * 32 + i0 + 4);
          const float cc[8] = {c0[0], c0[1], c0[2], c0[3], c1[0], c1[1], c1[2], c1[3]}, sn[8] = {s0[0], s0[1], s0[2], s0[3], s1[0], s1[1], s1[2], s1[3]};
          float x1[8], x2[8], y1[8], y2[8];
          unpack8(*reinterpret_cast<u32x4*>(&qr[8 + pp]), x1); unpack8(*reinterpret_cast<u32x4*>(&qr[10 + pp]), x2);
#pragma unroll
          for (int e = 0; e < 8; ++e) { y1[e] = x1[e] * cc[e] - x2[e] * sn[e]; y2[e] = x1[e] * sn[e] + x2[e] * cc[e]; }
          u32x4 w1 = pack8f(y1), w2 = pack8f(y2);
          qr[8 + pp] = *reinterpret_cast<bf16x8*>(&w1); qr[10 + pp] = *reinterpret_cast<bf16x8*>(&w2);
      } }
    const int NT = 4 * qb + 1;
    float m_reg = -1e30f, l_reg = 0; f32x16 o[4] = {};
    const int krow = tid >> 3, kc8 = tid & 7;
    const int kwr = krow * 384 + ((kc8 ^ ((krow >> 1) & 7)) << 4);
    const int sr = tid >> 4, sc = (tid & 15) * 8;
    const int vst0 = v_st(sr, sc), vst1 = v_st(32 + sr, sc);
    const unsigned vb0 = (unsigned)(uintptr_t)V_lds + (unsigned)v_rd_base(lane);
    bf16x8 sk[3], sv[2];
#define LOADT(t) do { const int kb_ = (3 + (t)) * KVBLK; const bf16_t* kp_ = kvf + (size_t)(kb_ + krow) * NKVF + head * 256 + kc8 * 8; \
        sk[0] = *(const bf16x8*)kp_; sk[1] = *(const bf16x8*)(kp_ + 64); sk[2] = *(const bf16x8*)(krr + (size_t)(kb_ + krow) * 64 + kc8 * 8); \
        sv[0] = *(const bf16x8*)(kvf + (size_t)(kb_ + sr) * NKVF + head * 256 + 128 + sc); sv[1] = *(const bf16x8*)(kvf + (size_t)(kb_ + 32 + sr) * NKVF + head * 256 + 128 + sc); } while (0)
#define WRITET(bf) do { _Pragma("unroll") for (int i = 0; i < 3; ++i) *(LAS bf16x8*)(K_lds + (bf) * SHM_K + kwr + 128 * i) = sk[i]; \
        *(LAS bf16x8*)(V_lds + (bf) * SHM_V + vst0) = sv[0]; *(LAS bf16x8*)(V_lds + (bf) * SHM_V + vst1) = sv[1]; } while (0)
#define RESC(a) do { if (__any((a) < 1.f)) { if (hi == 0) al_l[r32] = (a); asm volatile("s_waitcnt lgkmcnt(0)" ::: "memory");              \
                     _Pragma("unroll") for (int d_ = 0; d_ < 4; ++d_) _Pragma("unroll") for (int r = 0; r < 16; ++r) o[d_][r] *= al_l[crow(r, hi)]; } } while (0)
#define STEP(t, BUF) do { \
        if ((t) + 1 < NT) LOADT((t) + 1); \
        f32x16 p0, p1; float mn, alpha; bf16x8 pa0, pa1, pa2, pa3; \
        qkt<BUF>(p0, p1, K_lds, r32, hi, qr); \
        { const int kb_ = (3 + (t)) * KVBLK; \
          if (kb_ + KVBLK - 1 > row_w0 || kb_ < RFIRST) { const float NEG = -__builtin_inff(); \
            _Pragma("unroll") for (int r = 0; r < 16; ++r) { const int key0 = kb_ + crow(r, hi); \
                if (key0 > qrow || key0 < RFIRST) p0[r] = NEG; if (key0 + 32 > qrow || key0 + 32 < RFIRST) p1[r] = NEG; } } } \
        partialSM(p0, p1, m_reg, mn, alpha); \
        RESC(alpha); \
        finishSM(p0, p1, alpha, l_reg, pa0, pa1, pa2, pa3); SBAR(); \
        pv_tile<BUF>(o, vb0, pa0, pa1, pa2, pa3); \
        if ((t) + 1 < NT) WRITET((BUF) ^ 1); \
        __syncthreads(); } while (0)
    LOADT(0); WRITET(0); __syncthreads();
    for (int t = 0; t < NT; t += 2) {
        STEP(t, 0);
        if (t + 1 < NT) STEP(t + 1, 1);
    }
    if (hi == 0) li_l[r32] = l_reg; asm volatile("s_waitcnt lgkmcnt(0)" ::: "memory");
    float rli[16];
#pragma unroll
    for (int r = 0; r < 16; ++r) rli[r] = __builtin_amdgcn_rcpf(li_l[crow(r, hi)]);
    bf16_t* Ow = hcat + (size_t)row_w0 * DM + 2048 + head * 128;
#pragma unroll
    for (int r = 0; r < 16; ++r) { const int orow = crow(r, hi);
#pragma unroll
        for (int d0 = 0; d0 < 4; ++d0) { const float v = o[d0][r] * rli[r]; const float vn = __shfl_xor(v, 1);
            if ((r32 & 1) == 0 && row_w0 + orow >= RFIRST) *(unsigned*)(Ow + (size_t)orow * DM + d0 * 32 + r32) = cvt_pk_bf16(v, vn); } }
#undef LOADT
#undef WRITET
#undef RESC
#undef STEP
}
}

namespace mls {
constexpr int QP = 528, VP = 272, SP = 144;
constexpr int Q_OFF = 0, K_OFF = 33792, V_OFF = 67584, S_OFF = 84992, SC_OFF = 94208, DEN_OFF = 110592, N_OFF = 110848;
__device__ __forceinline__ f32x4 mfma16(bf16x8 a, bf16x8 b, f32x4 c) { return __builtin_amdgcn_mfma_f32_16x16x32_bf16(a, b, c, 0, 0, 0); }
#define TR64(dst, addr, off) asm volatile("ds_read_b64_tr_b16 %0, %1 offset:%2" : "=&v"(dst) : "v"(addr), "i"(off) : "memory")

__device__ __forceinline__ void mlstm_unit(LAS unsigned char* lds, int h, int sl, const bf16_t* qc, const bf16_t* kc, const bf16_t* z, const float* li, const float* lf, float* hm) {
    const int tid = opaque(threadIdx.x), wave = __builtin_amdgcn_readfirstlane(tid >> 6), lane = tid & 63, n16 = lane & 15, g = lane >> 4;
    const int tq = (lane >> 2) & 3, tp = lane & 3;
    const unsigned lbase = (unsigned)(uintptr_t)lds;
    LAS float* sc_u = (LAS float*)(lds + SC_OFF + wave * 2048); LAS float* sc_vv = sc_u + 64; LAS float* sc_wi = sc_u + 128; LAS float* sc_fl = sc_u + 192; LAS float* sc_ew = sc_u + 256;
    LAS float* den_l = (LAS float*)(lds + DEN_OFF); LAS float* nbuf = (LAS float*)(lds + N_OFF);
    const int dvb = sl * 128 + wave * 16;
    f32x4 Cacc[16];
#pragma unroll
    for (int i = 0; i < 16; ++i) Cacc[i] = (f32x4){0.f, 0.f, 0.f, 0.f};
    float m_c = 0.f;
    nbuf[tid] = 0.f;
    bf16x8 sq[4], sk[4], sv[2];
    const int srow = tid >> 5, sch = tid & 31, vrow0 = tid >> 4, vch = tid & 15;
    const bf16_t* gq = qc + (size_t)srow * 1024 + h * 256 + sch * 8; const bf16_t* gk = kc + (size_t)srow * 1024 + h * 256 + sch * 8;
    const bf16_t* gv = z + (size_t)vrow0 * NIN + ZV + h * 512 + sl * 128 + vch * 8;
    LAS unsigned char* wq = lds + Q_OFF + srow * QP + sch * 16; LAS unsigned char* wv = lds + V_OFF + vrow0 * VP + vch * 16;
#define ML_LOAD(c) do { const size_t r0_ = (size_t)(c) * 64; \
        _Pragma("unroll") for (int i = 0; i < 4; ++i) { sq[i] = *(const bf16x8*)(gq + (r0_ + 16 * i) * 1024); sk[i] = *(const bf16x8*)(gk + (r0_ + 16 * i) * 1024); } \
        sv[0] = *(const bf16x8*)(gv + r0_ * NIN); sv[1] = *(const bf16x8*)(gv + (r0_ + 32) * NIN); } while (0)
#define ML_WRITE() do { _Pragma("unroll") for (int i = 0; i < 4; ++i) { *(LAS bf16x8*)(wq + i * 16 * QP) = sq[i]; *(LAS bf16x8*)(wq + (K_OFF - Q_OFF) + i * 16 * QP) = sk[i]; } \
        *(LAS bf16x8*)(wv) = sv[0]; *(LAS bf16x8*)(wv + 32 * VP) = sv[1]; } while (0)
    LAS const unsigned char* qrow_b = lds + Q_OFF + n16 * QP + g * 16;
    LAS const unsigned char* qsub_b = lds + Q_OFF + n16 * QP + (g >> 1) * 16 + (g & 1) * 8;
    LAS const unsigned char* srow_b = lds + S_OFF + n16 * SP + g * 16;
    const unsigned ktr_b = lbase + K_OFF + (8 * g + tq) * QP + (tp >> 1) * 16 + (tp & 1) * 8;
    const unsigned vtr_b = lbase + V_OFF + (8 * g + tq) * VP + (2 * wave + (tp >> 1)) * 16 + (tp & 1) * 8;
    ML_LOAD(3); ML_WRITE(); __syncthreads();
    for (int c = 3; c < NCHUNK; ++c) {
        if (c + 1 < NCHUNK) ML_LOAD(c + 1);
        const size_t r0 = (size_t)c * 64;
        const float li_t = li[(r0 + lane) * 4 + h], lf_t = lf[(r0 + lane) * 4 + h];
        float b = lf_t;
#pragma unroll
        for (int o = 1; o < 64; o <<= 1) { const float t_ = __shfl_up(b, o); if (lane >= o) b += t_; }
        const float vv = li_t - b;
        float pm = vv;
#pragma unroll
        for (int o = 1; o < 64; o <<= 1) { const float t_ = __shfl_up(pm, o); if (lane >= o) pm = fmaxf(pm, t_); }
        const float gl = __shfl(b, 63), vvmax = __shfl(pm, 63);
        const float mt_ = fmaxf(b + m_c, b + pm);
        const float u_t = b - mt_;
        const float m_next = fmaxf(gl + m_c, gl + vvmax);
        const float decay = fexp(gl + m_c - m_next);
        sc_u[lane] = u_t; sc_vv[lane] = vv; sc_wi[lane] = fexp(u_t + m_c); sc_fl[lane] = fexp(-mt_); sc_ew[lane] = fexp(gl + vv - m_next);
        LDS_WAIT();
        {
            const int tT = wave >> 1, sT0 = 2 * (wave & 1);
            f32x4 s0 = (f32x4){0.f, 0.f, 0.f, 0.f}, s1 = s0;
            if (sT0 <= tT) {
                LAS const unsigned char* ab = qrow_b + tT * 16 * QP; LAS const unsigned char* bb = qrow_b + (K_OFF - Q_OFF) + sT0 * 16 * QP;
#pragma unroll
                for (int ks = 0; ks < 8; ++ks) {
                    const bf16x8 a = *(const LAS bf16x8*)(ab + ks * 64);
                    const bf16x8 b0 = *(const LAS bf16x8*)(bb + ks * 64);
                    const bf16x8 b1 = *(const LAS bf16x8*)(bb + 16 * QP + ks * 64);
                    s0 = mfma16(a, b0, s0); s1 = mfma16(a, b1, s1);
                    if ((ks & 3) == 3) SBAR();
                }
            }
#pragma unroll
            for (int jj = 0; jj < 2; ++jj) {
                const int s_ = 16 * (sT0 + jj) + n16; const float vvs = sc_vv[s_];
#pragma unroll
                for (int i = 0; i < 4; ++i) { const int t_ = 16 * tT + 4 * g + i;
                    const float sv_ = (jj == 0 ? s0[i] : s1[i]);
                    const float val = (s_ <= t_) ? sv_ * fexp(sc_u[t_] + vvs) : 0.f;
                    *(LAS unsigned short*)(lds + S_OFF + t_ * SP + s_ * 2) = f2bf(val); }
            }
        }
        f32x4 acc[4];
#pragma unroll
        for (int mt = 0; mt < 4; ++mt) acc[mt] = (f32x4){0.f, 0.f, 0.f, 0.f};
#pragma unroll
        for (int i = 0; i < 8; ++i) {
            u32x4 bw; bw.x = cvt_pk_bf16(Cacc[2 * i][0], Cacc[2 * i][1]); bw.y = cvt_pk_bf16(Cacc[2 * i][2], Cacc[2 * i][3]);
            bw.z = cvt_pk_bf16(Cacc[2 * i + 1][0], Cacc[2 * i + 1][1]); bw.w = cvt_pk_bf16(Cacc[2 * i + 1][2], Cacc[2 * i + 1][3]);
            const bf16x8 bfr = *reinterpret_cast<bf16x8*>(&bw);
#pragma unroll
            for (int mt = 0; mt < 4; ++mt) {
                const u32x2 lo = *(const LAS u32x2*)(qsub_b + mt * 16 * QP + i * 64);
                const u32x2 hi2 = *(const LAS u32x2*)(qsub_b + mt * 16 * QP + i * 64 + 32);
                u32x4 aw = (u32x4){lo.x, lo.y, hi2.x, hi2.y};
                acc[mt] = mfma16(*reinterpret_cast<bf16x8*>(&aw), bfr, acc[mt]); }
            if (i & 1) SBAR();
        }
#pragma unroll
        for (int mt = 0; mt < 4; ++mt)
#pragma unroll
            for (int i = 0; i < 4; ++i) acc[mt][i] *= sc_wi[16 * mt + 4 * g + i];
        __syncthreads();
        LAS const float* ncur = nbuf + (c & 1) * 256; LAS float* nnext = nbuf + ((c + 1) & 1) * 256;
        {
            const int t_ = 8 * wave + (lane >> 3), seg = lane & 7;
            float sv8[8]; unpack8(*(const LAS u32x4*)(lds + S_OFF + t_ * SP + seg * 16), sv8);
            float rsum = ((sv8[0] + sv8[1]) + (sv8[2] + sv8[3])) + ((sv8[4] + sv8[5]) + (sv8[6] + sv8[7]));
            float qn = 0.f;
#pragma unroll
            for (int cc = 0; cc < 4; ++cc) { float q8[8]; unpack8(*(const LAS u32x4*)(lds + Q_OFF + t_ * QP + (4 * seg + cc) * 16), q8);
                const f32x4 n0 = *(const LAS f32x4*)(ncur + 32 * seg + 8 * cc), n1 = *(const LAS f32x4*)(ncur + 32 * seg + 8 * cc + 4);
                qn += (q8[0] * n0[0] + q8[1] * n0[1]) + (q8[2] * n0[2] + q8[3] * n0[3]) + (q8[4] * n1[0] + q8[5] * n1[1]) + (q8[6] * n1[2] + q8[7] * n1[3]); }
            rsum += __shfl_xor(rsum, 1); rsum += __shfl_xor(rsum, 2); rsum += __shfl_xor(rsum, 4);
            qn += __shfl_xor(qn, 1); qn += __shfl_xor(qn, 2); qn += __shfl_xor(qn, 4);
            if (seg == 0) den_l[t_] = sc_wi[t_] * qn + rsum;
        }
        if (tid < 256) { float nn = decay * ncur[tid]; LAS const unsigned char* kp = lds + K_OFF + tid * 2;
#pragma unroll 8
            for (int s_ = 0; s_ < 64; ++s_) nn += sc_ew[s_] * bf2f(*(const LAS unsigned short*)(kp + s_ * QP));
            nnext[tid] = nn; }
        bf16x8 vB[2];
        { s16x4 l0, h0, l1, h1;
          TR64(l0, vtr_b, 0); TR64(h0, vtr_b, 4 * VP); TR64(l1, vtr_b, 32 * VP); TR64(h1, vtr_b, 36 * VP); LDS_WAIT(); SBAR();
          vB[0] = (bf16x8){l0[0], l0[1], l0[2], l0[3], h0[0], h0[1], h0[2], h0[3]}; vB[1] = (bf16x8){l1[0], l1[1], l1[2], l1[3], h1[0], h1[1], h1[2], h1[3]}; }
#pragma unroll
        for (int ks = 0; ks < 2; ++ks)
#pragma unroll
            for (int mt = 0; mt < 4; ++mt) {
                const bf16x8 a = *(const LAS bf16x8*)(srow_b + mt * 16 * SP + ks * 64);
                acc[mt] = mfma16(a, vB[ks], acc[mt]); }
        __syncthreads();
        { float* hp = hm + (r0 + 4 * g) * 2048 + h * 512 + dvb + n16;
#pragma unroll
          for (int mt = 0; mt < 4; ++mt)
#pragma unroll
            for (int i = 0; i < 4; ++i) { const int t_ = 16 * mt + 4 * g + i; const float d = fmaxf(fabsf(den_l[t_]), sc_fl[t_]);
                hp[(size_t)(16 * mt + i) * 2048] = acc[mt][i] / d; } }
        bf16x8 vBs[2];
#pragma unroll
        for (int ks = 0; ks < 2; ++ks) { float f8[8]; unpack8(*reinterpret_cast<u32x4*>(&vB[ks]), f8);
#pragma unroll
            for (int j = 0; j < 8; ++j) f8[j] *= sc_ew[32 * ks + 8 * g + j];
            u32x4 w = pack8f(f8); vBs[ks] = *reinterpret_cast<bf16x8*>(&w); }
#pragma unroll
        for (int i = 0; i < 16; ++i) Cacc[i] *= decay;
#define ML_UPD(ks, ib) do { s16x4 l0, h0, l1, h1, l2, h2, l3, h3; constexpr int o_ = (ks) * 32 * QP + (ib) * 32; \
            TR64(l0, ktr_b, o_); TR64(h0, ktr_b, o_ + 4 * QP); TR64(l1, ktr_b, o_ + 32); TR64(h1, ktr_b, o_ + 32 + 4 * QP); \
            TR64(l2, ktr_b, o_ + 64); TR64(h2, ktr_b, o_ + 64 + 4 * QP); TR64(l3, ktr_b, o_ + 96); TR64(h3, ktr_b, o_ + 96 + 4 * QP); LDS_WAIT(); SBAR(); \
            Cacc[(ib) + 0] = mfma16((bf16x8){l0[0], l0[1], l0[2], l0[3], h0[0], h0[1], h0[2], h0[3]}, vBs[ks], Cacc[(ib) + 0]); \
            Cacc[(ib) + 1] = mfma16((bf16x8){l1[0], l1[1], l1[2], l1[3], h1[0], h1[1], h1[2], h1[3]}, vBs[ks], Cacc[(ib) + 1]); \
            Cacc[(ib) + 2] = mfma16((bf16x8){l2[0], l2[1], l2[2], l2[3], h2[0], h2[1], h2[2], h2[3]}, vBs[ks], Cacc[(ib) + 2]); \
            Cacc[(ib) + 3] = mfma16((bf16x8){l3[0], l3[1], l3[2], l3[3], h3[0], h3[1], h3[2], h3[3]}, vBs[ks], Cacc[(ib) + 3]); } while (0)
        ML_UPD(0, 0); ML_UPD(0, 4); ML_UPD(0, 8); ML_UPD(0, 12); ML_UPD(1, 0); ML_UPD(1, 4); ML_UPD(1, 8); ML_UPD(1, 12);
#undef ML_UPD
        m_c = m_next;
        __syncthreads();
        if (c + 1 < NCHUNK) ML_WRITE();
        __syncthreads();
    }
#undef ML_LOAD
#undef ML_WRITE
}
#undef TR64
}

constexpr int LDS_BYTES = 147456;
constexpr int MISC_OFF = 131072 + 4096;
constexpr int NPHASE = 21;
struct Args { Ptrs p; int ph_lo, ph_hi; };

__global__ void __launch_bounds__(512, 2) fwd_kernel(Args args) {
    extern __shared__ __attribute__((aligned(16))) unsigned char lds_raw[];
    LAS unsigned char* lds = (LAS unsigned char*)lds_raw;
    volatile LAS unsigned* MISC = (volatile LAS unsigned*)(lds + MISC_OFF);
    const int tid = threadIdx.x, lane = tid & 63, wave = __builtin_amdgcn_readfirstlane(tid >> 6);
    const int G = gridDim.x; const int bx = blockIdx.x;
    const int gw = bx * 8 + wave, NGW = G * 8;
    const Ptrs& P = args.p;
    unsigned char* ws = P.ws;
    unsigned* ctl = (unsigned*)(ws + WS_CTL);
    if (tid < 64) MISC[tid] = 0u;
    __syncthreads();
#if MK_PER_PHASE
    XcdBarrier bar; bar.bar = ctl + CW_BAR; bar.x = 0; bar.st = nullptr;
#define GRID_BAR() do { } while (0)
#else
    XcdBarrier bar = xcd_barrier_post(ctl + CW_BAR, MISC + 8);
#define GRID_BAR() xcd_barrier(bar)
#endif
    const int lo = args.ph_lo, hi = args.ph_hi;
#ifndef PH_MASK
#define PH_MASK 0xFFFF
#endif
#define PHON(t) (((PH_MASK) >> (t)) & 1)
#define IN(k) (lo <= (k) && (k) < hi)
#define BOTH(k) (IN(k) && IN((k) + 1))

    float* hres = (float*)(ws + WS_HRES); bf16_t* u = (bf16_t*)(ws + WS_U); bf16_t* z = (bf16_t*)(ws + WS_Z);
    bf16_t* qc = (bf16_t*)(ws + WS_QC); bf16_t* kc = (bf16_t*)(ws + WS_KC); bf16_t* cqn = (bf16_t*)(ws + WS_CQN); bf16_t* ckvn = (bf16_t*)(ws + WS_CKVN);
    bf16_t* krr = (bf16_t*)(ws + WS_KRR); bf16_t* qf = (bf16_t*)(ws + WS_QF); bf16_t* kvf = (bf16_t*)(ws + WS_KVF); float* hm = (float*)(ws + WS_HM);
    bf16_t* hcat = (bf16_t*)(ws + WS_HCAT); bf16_t* mix = z; bf16_t* act = z; bf16_t* yb = kvf;
    float* cosT = (float*)(ws + WS_COS); float* sinT = (float*)(ws + WS_SIN); float* li = (float*)(ws + WS_LI); float* lf = (float*)(ws + WS_LF);

    if (PHON(0) && IN(0)) { p_prologue(P, lds, gw, NGW, wave, lane); if (BOTH(0)) GRID_BAR(); }

#pragma unroll 1
    for (int l = 0; l < 2; ++l) {
        const int pb = 1 + 10 * l;
        if (PHON(1) && IN(pb + 0)) {
            pg8::Gemm g{u, w_ptr(ws, l, 0), R, NIN, DM, DM, DM}; pg8::StaticOrder S; S.init(R, NIN, G, bx);
            pg8::EpiBf16 E{z, NIN};
            pg8::gemm_phase<pg8::EpiBf16>(lds, g, S, E);
            if (BOTH(pb + 0)) GRID_BAR();
        }
        if (PHON(2) && IN(pb + 1)) {
            p_prep(z, P.in[4] + (size_t)l * 4 * 2048, P.in[5] + l * 8, P.in[7] + (size_t)l * QL, P.in[9] + (size_t)l * KVL, cosT, sinT, qc, kc, li, lf, cqn, ckvn, krr, gw, NGW, lane);
            if (BOTH(pb + 1)) GRID_BAR();
        }
        if (PHON(3) && IN(pb + 2)) {
#pragma unroll 1
            for (int gi = 0; gi < 2; ++gi) {
                pg8::Gemm g{gi ? ckvn : cqn, w_ptr(ws, l, gi ? 2 : 1), R, gi ? NKVF : NQF, gi ? KVL : QL, gi ? KVL : QL, gi ? KVL : QL};
                pg8::StaticOrder S; S.init(R, g.N, G, bx);
                pg8::EpiBf16 E{gi ? kvf : qf, g.N}; pg8::gemm_phase<pg8::EpiBf16>(lds, g, S, E);
                __syncthreads();
            }
            if (BOTH(pb + 2)) GRID_BAR();
        }
        if (PHON(4) && IN(pb + 3)) {
            unsigned* qhead = ctl + CW_Q + 64 * l;
            constexpr int NUNITS = 16 + NQB * 16;
            for (;;) {
                __syncthreads();
                if (tid == 0) MISC[0] = __hip_atomic_fetch_add(qhead, 1u, __ATOMIC_RELAXED, __HIP_MEMORY_SCOPE_AGENT);
                __syncthreads();
                const int un = (int)MISC[0];
                if (un >= NUNITS) break;
                if (un < 16) { if (!PHON(16)) mls::mlstm_unit(lds, un >> 2, un & 3, qc, kc, z, li, lf, hm); }
                else if (!PHON(17)) { const int i = un - 16; att::attn_unit((LAS char*)lds, i & 15, (NQB - 1) - (i >> 4), qf, kvf, krr, cosT, sinT, hcat); }
            }
            if (BOTH(pb + 3)) GRID_BAR();
        }
        if (PHON(5) && IN(pb + 4)) {
            p_hcat(hm, z, P.in[6] + (size_t)l * 2048, hcat, gw, NGW, lane);
            if (BOTH(pb + 4)) GRID_BAR();
        }
        if (PHON(6) && IN(pb + 5)) {
            pg8::Gemm g{hcat, w_ptr(ws, l, 3), R, DM, DM, DM, DM}; pg8::StaticOrder S; S.init(R, DM, G, bx);
            pg8::EpiBf16 E{mix, DM}; pg8::gemm_phase<pg8::EpiBf16>(lds, g, S, E);
            if (BOTH(pb + 5)) GRID_BAR();
        }
        if (PHON(7) && IN(pb + 6)) {
            p_resnorm(mix, hres, P.in[12] + (size_t)l * DM, P.in[13] + (size_t)l * DM, u, nullptr, gw, NGW, lane);
            if (BOTH(pb + 6)) GRID_BAR();
        }
        if (PHON(8) && IN(pb + 7)) {
            pg8::Gemm g{u, w_ptr(ws, l, 4), R, NGU, DM, DM, DM}; pg8::StaticOrder S; S.init(R, NGU, G, bx);
            pg8::EpiSwiGLU E{act, DFF}; pg8::gemm_phase<pg8::EpiSwiGLU>(lds, g, S, E);
            if (BOTH(pb + 7)) GRID_BAR();
        }
        if (PHON(9) && IN(pb + 8)) {
            pg8::Gemm g{act, w_ptr(ws, l, 5), R, DM, DFF, DFF, DFF}; pg8::StaticOrder S; S.init(R, DM, G, bx);
            pg8::EpiBf16 E{yb, DM}; pg8::gemm_phase<pg8::EpiBf16>(lds, g, S, E);
            if (BOTH(pb + 8)) GRID_BAR();
        }
        if (PHON(10) && IN(pb + 9)) {
            if (l == 0) p_resnorm(yb, hres, P.in[16], P.in[2] + DM, u, nullptr, gw, NGW, lane);
            else p_resnorm(yb, hres, P.in[16] + DM, nullptr, nullptr, P.out, gw, NGW, lane);
            if (BOTH(pb + 9)) GRID_BAR();
        }
    }
#undef IN
#undef BOTH
}

extern "C" void kernel_launch(void* const* d_in, const int* in_sizes, int n_in, void* d_out, int out_size, void* d_ws, size_t ws_size, hipStream_t stream) {
    static int grid = 0;
    if (grid == 0) {
        if (n_in != 17 || out_size != SEQ * DM || ws_size < WS_END) { fprintf(stderr, "kernel_launch: unexpected shapes (n_in %d, out %d, ws %zu < %zu)\n", n_in, out_size, ws_size, (size_t)WS_END); grid = -1; return; }
        int dev = 0, cus = 0, per_cu = 0;
        if (hipGetDevice(&dev) != hipSuccess || hipDeviceGetAttribute(&cus, hipDeviceAttributeMultiprocessorCount, dev) != hipSuccess) { grid = -1; return; }
        if (hipFuncSetAttribute((const void*)fwd_kernel, hipFuncAttributeMaxDynamicSharedMemorySize, LDS_BYTES) != hipSuccess) { fprintf(stderr, "kernel_launch: hipFuncSetAttribute failed\n"); grid = -1; return; }
        if (hipOccupancyMaxActiveBlocksPerMultiprocessor(&per_cu, (const void*)fwd_kernel, 512, LDS_BYTES) != hipSuccess || per_cu < 1) fprintf(stderr, "kernel_launch: occupancy query reports %d\n", per_cu);
        (void)hipGetLastError();
        grid = cus;
    }
    if (grid < 0) return;
    (void)hipMemsetAsync((char*)d_ws + WS_CTL, 0, CTL_BYTES, stream);
    Args a{};
    for (int i = 0; i < 17; ++i) a.p.in[i] = (const float*)d_in[i];
    a.p.out = (float*)d_out; a.p.ws = (unsigned char*)d_ws;
#if MK_PER_PHASE
    for (int ph = 0; ph < NPHASE; ++ph) { a.ph_lo = ph; a.ph_hi = ph + 1; hipLaunchKernelGGL(fwd_kernel, dim3(grid), dim3(512), LDS_BYTES, stream, a); }
#else
    a.ph_lo = 0; a.ph_hi = NPHASE;
    hipLaunchKernelGGL(fwd_kernel, dim3(grid), dim3(512), LDS_BYTES, stream, a);
#endif
}
```

```cpp
#include <hip/hip_runtime.h>
#include <cstdio>
#include <cstdint>

#ifndef MK_PER_PHASE
#define MK_PER_PHASE 0
#endif

#define LAS __attribute__((address_space(3)))
typedef unsigned short bf16_t;
typedef short bf16x8 __attribute__((ext_vector_type(8)));
typedef short s16x4 __attribute__((ext_vector_type(4)));
typedef float f32x4 __attribute__((ext_vector_type(4)));
typedef float f32x16 __attribute__((ext_vector_type(16)));
typedef unsigned u32x4 __attribute__((ext_vector_type(4)));
typedef unsigned u32x2 __attribute__((ext_vector_type(2)));

constexpr int DM = 4096, SEQ = 16384, NMETA = 16;
constexpr int RFIRST = 240;
constexpr int R = 16640;
constexpr int NIN = 8448;
constexpr int ZQ = 0, ZK = 1024, ZV = 2048, ZO = 4096, ZCQ = 6144, ZCKV = 7680, ZKR = 8192, ZGI = 8256, ZGF = 8260;
constexpr int NIN_SRC = 8264;
constexpr int QL = 1536, KVL = 512, NQF = 3072, NKVF = 4096;
constexpr int DFF = 11008, NGU = 22016;
constexpr float EPS = 1e-6f;
constexpr int NCHUNK = R / 64;
constexpr int NQB = R / 256;

constexpr size_t MiB = 1u << 20;
constexpr size_t WS_CTL = 0, CTL_BYTES = 1 * MiB;
constexpr size_t WS_COS = 2 * MiB, WS_SIN = 5 * MiB;
constexpr size_t WS_LI = 8 * MiB, WS_LF = 9 * MiB;
constexpr size_t SZ_WIN = (size_t)NIN * DM * 2, SZ_WUQ = (size_t)NQF * QL * 2, SZ_WUKV = (size_t)NKVF * KVL * 2,
                 SZ_WOUT = (size_t)DM * DM * 2, SZ_WGU = (size_t)NGU * DM * 2, SZ_WDN = (size_t)DM * DFF * 2;
constexpr size_t SZ_WL = SZ_WIN + SZ_WUQ + SZ_WUKV + SZ_WOUT + SZ_WGU + SZ_WDN;
constexpr size_t WS_W = 16 * MiB;
constexpr size_t WS_HRES = WS_W + 2 * SZ_WL;
constexpr size_t WS_U = WS_HRES + (size_t)R * DM * 4;
constexpr size_t WS_Z = WS_U + (size_t)R * DM * 2;
constexpr size_t WS_QC = WS_Z + (size_t)R * NIN * 2;
constexpr size_t WS_KC = WS_QC + (size_t)R * 1024 * 2;
constexpr size_t WS_CQN = WS_KC + (size_t)R * 1024 * 2;
constexpr size_t WS_CKVN = WS_CQN + (size_t)R * QL * 2;
constexpr size_t WS_KRR = WS_CKVN + (size_t)R * KVL * 2;
constexpr size_t WS_QF = WS_KRR + (size_t)R * 64 * 2;
constexpr size_t WS_KVF = WS_QF + (size_t)R * NQF * 2;
constexpr size_t WS_HM = WS_KVF + (size_t)R * NKVF * 2;
constexpr size_t WS_HCAT = WS_HM + (size_t)R * 2048 * 4;
constexpr size_t WS_CST = WS_HCAT + (size_t)R * DM * 2;
constexpr size_t WS_NST = WS_CST + (size_t)3 * 16 * 512 * 64 * 4;
constexpr size_t WS_END = WS_NST + (size_t)3 * 16 * 256 * 4;
static_assert((size_t)R * DFF * 2 <= WS_CKVN - WS_Z, "act overlay fits in z|qc|kc|cqn");
constexpr int CW_BAR = 4096;
constexpr int CW_Q = 16384;
constexpr int CW_P1 = 32768;

__device__ __forceinline__ float bf2f(unsigned short b) { return __uint_as_float(((unsigned)b) << 16); }
__device__ __forceinline__ float bflo(unsigned w) { return __uint_as_float(w << 16); }
__device__ __forceinline__ float bfhi(unsigned w) { return __uint_as_float(w & 0xffff0000u); }
__device__ __forceinline__ unsigned cvt_pk_bf16(float lo, float hi) { unsigned r; asm volatile("v_cvt_pk_bf16_f32 %0, %1, %2" : "=v"(r) : "v"(lo), "v"(hi)); return r; }
__device__ __forceinline__ unsigned short f2bf(float f) { return (unsigned short)(cvt_pk_bf16(f, 0.f) & 0xffffu); }
__device__ __forceinline__ float wave_sum(float v) {
#pragma unroll
    for (int o = 1; o < 64; o <<= 1) v += __shfl_xor(v, o);
    return v;
}
__device__ __forceinline__ float fexp(float x) { return __builtin_amdgcn_exp2f(x * 1.4426950408889634f); }
__device__ __forceinline__ int opaque(int x) { asm volatile("" : "+v"(x)); return x; }
#define LDS_WAIT() asm volatile("s_waitcnt lgkmcnt(0)" ::: "memory")
#define SBAR() __builtin_amdgcn_sched_barrier(0)

#define XB_TMO      128
#define XB_XCNT(j)  (256  + 64 * (j))
#define XB_XSUB(j)  (1280 + 64 * (j))
#define XB_XGEN(j)  (2304 + 64 * (j))
#define XB_TOP      3328
#define XB_TOPGEN   3392
#define XCD_BAR_WORDS 3456
#define XB_SPIN_CAP (1u << 20)

__device__ __forceinline__ unsigned xb_ld(unsigned* p)              { return __hip_atomic_load(p, __ATOMIC_RELAXED, __HIP_MEMORY_SCOPE_AGENT); }
__device__ __forceinline__ unsigned xb_add(unsigned* p, unsigned v) { return __hip_atomic_fetch_add(p, v, __ATOMIC_RELAXED, __HIP_MEMORY_SCOPE_AGENT); }
__device__ __forceinline__ unsigned xb_xcc_id() { return (unsigned)__builtin_amdgcn_s_getreg((3 << 11) | 20) & 0xFu; }
#define XB_SPIN(cond, bar) do { unsigned _sp = 0; while (cond) { __builtin_amdgcn_s_sleep(1); \
    if ((++_sp & 255u) == 0u) { if (xb_ld(&(bar)[XB_TMO])) break; if (_sp > XB_SPIN_CAP) { atomicAdd(&(bar)[XB_TMO], 1u); break; } } } } while (0)

struct XcdBarrier { unsigned* bar; unsigned x; volatile LAS unsigned* st; };

__device__ __forceinline__ XcdBarrier xcd_barrier_post(unsigned* bar, volatile LAS unsigned* st) {
    XcdBarrier b; b.bar = bar; b.x = xb_xcc_id(); b.st = st;
    if (threadIdx.x == 0) (void)xb_add(&bar[XB_XCNT(b.x)], 1u);
    return b;
}
__device__ __forceinline__ void xcd_barrier_complete(unsigned* bar, unsigned x, unsigned& nloc, unsigned& nx) {
    const unsigned G = gridDim.x * gridDim.y * gridDim.z;
    unsigned sum, cnt, mine, sp = 0u;
    for (;;) {
        sum = 0u; cnt = 0u; mine = 0u;
#pragma unroll
        for (unsigned j = 0; j < 16; ++j) { const unsigned c = xb_ld(&bar[XB_XCNT(j)]); sum += c; cnt += (c > 0u) ? 1u : 0u; mine = (j == x) ? c : mine; }
        if (sum == G) break;
        __builtin_amdgcn_s_sleep(1);
        if ((++sp & 255u) == 0u) { if (xb_ld(&bar[XB_TMO])) break; if (sp > XB_SPIN_CAP) { atomicAdd(&bar[XB_TMO], 1u); break; } }
    }
    nloc = mine > 0u ? mine : 1u; nx = cnt > 0u ? cnt : 1u;
}
__device__ __forceinline__ void xcd_barrier(const XcdBarrier& b) {
    asm volatile("s_waitcnt vmcnt(0)" ::: "memory");
    __syncthreads();
    if (threadIdx.x == 0) {
        unsigned* bar = b.bar;
        __builtin_amdgcn_s_waitcnt(0);
        unsigned nloc = b.st[0], nx = b.st[1];
        if (nloc == 0u) { xcd_barrier_complete(bar, b.x, nloc, nx); b.st[0] = nloc; b.st[1] = nx; }
        const unsigned old = xb_add(&bar[XB_XSUB(b.x)], 1u);
        const unsigned gen = old / nloc;
        if (old + 1u == (gen + 1u) * nloc) {
            __builtin_amdgcn_fence(__ATOMIC_RELEASE, "agent");
            asm volatile("s_waitcnt vmcnt(0)" ::: "memory");
            const unsigned og = xb_add(&bar[XB_TOP], 1u);
            const unsigned tg = og / nx;
            if (og + 1u == (tg + 1u) * nx) xb_add(&bar[XB_TOPGEN], 1u);
            else XB_SPIN(xb_ld(&bar[XB_TOPGEN]) == tg, bar);
            __builtin_amdgcn_fence(__ATOMIC_ACQUIRE, "agent");
            xb_add(&bar[XB_XGEN(b.x)], 1u);
            asm volatile("s_waitcnt vmcnt(0)" ::: "memory");
        } else {
            XB_SPIN(xb_ld(&bar[XB_XGEN(b.x)]) == gen, bar);
            __builtin_amdgcn_fence(__ATOMIC_ACQUIRE, "agent");
            asm volatile("s_waitcnt vmcnt(0)" ::: "memory");
        }
    }
    __syncthreads();
}

namespace pg8 {
constexpr int BM = 256, BK = 64, HALF = 128, HTB = HALF * BK * 2, STAGE_BYTES = 8 * HTB, NXCD = 8, WGM = 8;
__device__ __forceinline__ int lds_byte(int r, int c) { const int st = (r >> 4) * 2 + (c >> 5), rr = r & 15, cc = c & 31, ob = rr * 64 + cc * 2; return st * 1024 + (ob ^ (((ob >> 9) & 1) << 5)); }
__device__ __forceinline__ void stage_rc(int b, int& R_, int& C) { const int st = b / 1024, sb = b % 1024, swz = sb ^ (((sb >> 9) & 1) << 5); R_ = (st >> 1) * 16 + swz / 64; C = (st & 1) * 32 + (swz % 64) / 2; }
__device__ __forceinline__ int perm32(int rho) { const int n = rho >> 4, i = rho & 15; return 8 * (i >> 2) + 4 * n + (i & 3); }
struct Unit { int pm, pn; };
struct Gemm { const bf16_t* A; const bf16_t* Bt; int M, N, K, lda, ldb; };
struct StaticOrder {
    int nM, nN, nwg, G, c;
    __device__ void init(int M, int N, int G_, int c_) { nM = M / BM; nN = N / BM; nwg = nM * nN; G = G_; c = c_; }
    __device__ bool next(int i, Unit& u) const {
        const long L = (long)i * G + c; if (L >= nwg) return false;
        int wgid = (int)L; { const int q = nwg / NXCD, r = nwg % NXCD, xcd = wgid % NXCD, off = wgid / NXCD; wgid = (xcd < r ? xcd * (q + 1) : r * (q + 1) + (xcd - r) * q) + off; }
        const int nig = WGM * nN, gid = wgid / nig, fm = gid * WGM, gsz = (nM - fm) < WGM ? (nM - fm) : WGM;
        u.pm = fm + ((wgid % nig) % gsz); u.pn = (wgid % nig) / gsz; return true;
    }
};
struct EpiBf16 {
    static constexpr bool PERM = true;
    bf16_t* O; int ldc;
    __device__ __forceinline__ void operator()(const f32x4 (&acc)[2][2][4][2], const Unit& u, int wr, int wc, int fr, int fq) const {
        const int row0 = u.pm * BM + wr * 64 + fr, col0 = u.pn * BM + wc * 32 + 8 * fq;
#pragma unroll
        for (int ai = 0; ai < 2; ++ai)
#pragma unroll
            for (int m = 0; m < 4; ++m) { bf16_t* rowp = O + (size_t)(row0 + ai * HALF + m * 16) * ldc + col0;
#pragma unroll
                for (int bj = 0; bj < 2; ++bj) { const f32x4 v0 = acc[ai][bj][m][0], v1 = acc[ai][bj][m][1];
                    u32x4 w; w.x = cvt_pk_bf16(v0[0], v0[1]); w.y = cvt_pk_bf16(v0[2], v0[3]); w.z = cvt_pk_bf16(v1[0], v1[1]); w.w = cvt_pk_bf16(v1[2], v1[3]);
                    *(u32x4*)(rowp + bj * HALF) = w; } }
    }
};
__device__ __forceinline__ float silu_mul(float g, float u) { return g * u * __builtin_amdgcn_rcpf(1.0f + __builtin_amdgcn_exp2f(-g * 1.4426950408889634f)); }
struct EpiSwiGLU {
    static constexpr bool PERM = true;
    bf16_t* O; int ldc;
    __device__ __forceinline__ void operator()(const f32x4 (&acc)[2][2][4][2], const Unit& u, int wr, int wc, int fr, int fq) const {
        const int row0 = u.pm * BM + wr * 64 + fr, col0 = u.pn * HALF + wc * 32 + 8 * fq;
#pragma unroll
        for (int ai = 0; ai < 2; ++ai)
#pragma unroll
            for (int m = 0; m < 4; ++m) { bf16_t* rowp = O + (size_t)(row0 + ai * HALF + m * 16) * ldc + col0;
                const f32x4 g0 = acc[ai][0][m][0], g1 = acc[ai][0][m][1], u0 = acc[ai][1][m][0], u1 = acc[ai][1][m][1];
                u32x4 w; w.x = cvt_pk_bf16(silu_mul(g0[0], u0[0]), silu_mul(g0[1], u0[1])); w.y = cvt_pk_bf16(silu_mul(g0[2], u0[2]), silu_mul(g0[3], u0[3]));
                w.z = cvt_pk_bf16(silu_mul(g1[0], u1[0]), silu_mul(g1[1], u1[1])); w.w = cvt_pk_bf16(silu_mul(g1[2], u1[2]), silu_mul(g1[3], u1[3]));
                *(u32x4*)rowp = w; }
    }
};

template <class Epi>
__device__ __forceinline__ void gemm_phase(LAS unsigned char* lds, const Gemm g, const StaticOrder& S, const Epi& E) {
    const int tid = opaque(threadIdx.x), wid = __builtin_amdgcn_readfirstlane(tid >> 6), lane = tid & 63, wr = wid >> 2, wc = wid & 3, fr = lane & 15, fq = lane >> 4;
    const int K = g.K, nt = K / BK;
    unsigned voffA[2], voffB[2];
#pragma unroll
    for (int i = 0; i < 2; ++i) { int R_, C; stage_rc(tid * 16 + i * 8192, R_, C); const int Rb = Epi::PERM ? ((R_ & ~31) + perm32(R_ & 31)) : R_;
        voffA[i] = (unsigned)(R_ * g.lda + C) * 2u; voffB[i] = (unsigned)(Rb * g.ldb + C) * 2u; }
    const size_t kstep = (size_t)(BK * 2);
    const size_t hstepA = (size_t)HALF * g.lda * 2, hstepB = (size_t)HALF * g.ldb * 2;
    const size_t tstepA = 2 * hstepA, tstepB = 2 * hstepB;
    const unsigned ldsw = (unsigned)wid * 1024u;
    const int aoff = lds_byte(wr * 64 + fr, fq * 8), boff = lds_byte(wc * 32 + fr, fq * 8);
#define PG8_SA(b, h) (((b) * 2 + (h)) * HTB)
#define PG8_SB(b, h) ((4 + (b) * 2 + (h)) * HTB)
#define PG8_STAGE(bufoff, gbase, voff) do { _Pragma("unroll") for (int _i = 0; _i < 2; ++_i) \
        __builtin_amdgcn_global_load_lds((const unsigned*)((const char*)(gbase) + (voff)[_i]), (LAS unsigned*)(lds + (bufoff) + ldsw + _i * 8192), 16, 0, 0); } while (0)
#define PG8_LDA(dst, b, h) do { _Pragma("unroll") for (int m = 0; m < 4; ++m) _Pragma("unroll") for (int k = 0; k < 2; ++k) dst[m][k] = *(const LAS bf16x8*)(lds + PG8_SA(b, h) + aoff + m * 2048 + k * 1024); } while (0)
#define PG8_LDB(dst, b, h) do { _Pragma("unroll") for (int n = 0; n < 2; ++n) _Pragma("unroll") for (int k = 0; k < 2; ++k) dst[n][k] = *(const LAS bf16x8*)(lds + PG8_SB(b, h) + boff + n * 2048 + k * 1024); } while (0)
#define PG8_MMA(ai, bj, At, Bt) do { __builtin_amdgcn_s_setprio(1); _Pragma("unroll") for (int m = 0; m < 4; ++m) _Pragma("unroll") for (int n = 0; n < 2; ++n) _Pragma("unroll") for (int k = 0; k < 2; ++k) \
        acc[ai][bj][m][n] = __builtin_amdgcn_mfma_f32_16x16x32_bf16(Bt[n][k], At[m][k], acc[ai][bj][m][n], 0, 0, 0); __builtin_amdgcn_s_setprio(0); } while (0)
#define PG8_WAIT_V(n) asm volatile("s_waitcnt vmcnt(" #n ")" ::: "memory")
#define PG8_WAIT_L(n) asm volatile("s_waitcnt lgkmcnt(" #n ")" ::: "memory")
#define PG8_BAR __builtin_amdgcn_s_barrier()
#define PG8_SCHED __builtin_amdgcn_sched_barrier(0)
    Unit cur, nxt; int ui = 0;
    if (!S.next(0, cur)) return;
    f32x4 acc[2][2][4][2];
#pragma unroll
    for (int a = 0; a < 2; ++a)
#pragma unroll
        for (int b = 0; b < 2; ++b)
#pragma unroll
            for (int m = 0; m < 4; ++m)
#pragma unroll
                for (int n = 0; n < 2; ++n) acc[a][b][m][n] = (f32x4){0.f, 0.f, 0.f, 0.f};
    bf16x8 At[4][2], B0[2][2], B1[2][2];
    const char* cA = (const char*)g.A + (size_t)cur.pm * tstepA; const char* cB = (const char*)g.Bt + (size_t)cur.pn * tstepB;
    PG8_STAGE(PG8_SB(0, 0), cB, voffB); PG8_STAGE(PG8_SA(0, 0), cA, voffA); PG8_STAGE(PG8_SB(0, 1), cB + hstepB, voffB); PG8_STAGE(PG8_SA(0, 1), cA + hstepA, voffA);
    if (wr == 1) PG8_BAR;
    PG8_WAIT_V(4); PG8_BAR;
    PG8_STAGE(PG8_SB(1, 0), cB + kstep, voffB); PG8_STAGE(PG8_SA(1, 0), cA + kstep, voffA); PG8_STAGE(PG8_SB(1, 1), cB + hstepB + kstep, voffB);
    PG8_WAIT_V(6); PG8_BAR;
    for (;;) {
        const bool has_next = S.next(ui + 1, nxt);
        const char* nA = has_next ? (const char*)g.A + (size_t)nxt.pm * tstepA : cA; const char* nB = has_next ? (const char*)g.Bt + (size_t)nxt.pn * tstepB : cB;
        for (int t = 0; t < nt; t += 2) {
            const bool last = (t == nt - 2);
            const char* a1 = cA + (size_t)(t + 1) * kstep;
            const char* a2 = last ? nA : cA + (size_t)(t + 2) * kstep; const char* b2 = last ? nB : cB + (size_t)(t + 2) * kstep;
            const char* a3 = a2 + kstep; const char* b3 = b2 + kstep;
            PG8_LDB(B0, 0, 0); PG8_SCHED; PG8_LDA(At, 0, 0); PG8_STAGE(PG8_SA(1, 1), a1 + hstepA, voffA);
            PG8_WAIT_L(8); PG8_BAR; PG8_WAIT_L(0); PG8_MMA(0, 0, At, B0); PG8_BAR; PG8_SCHED;
            PG8_LDB(B1, 0, 1); PG8_STAGE(PG8_SB(0, 0), b2, voffB);
            PG8_BAR; PG8_WAIT_L(0); PG8_MMA(0, 1, At, B1); PG8_BAR;
            PG8_LDA(At, 0, 1); PG8_STAGE(PG8_SA(0, 0), a2, voffA);
            PG8_BAR; PG8_WAIT_L(0); PG8_MMA(1, 0, At, B0); PG8_BAR; PG8_SCHED;
            PG8_STAGE(PG8_SB(0, 1), b2 + hstepB, voffB);
            PG8_WAIT_V(6); PG8_BAR; PG8_MMA(1, 1, At, B1); PG8_BAR;
            PG8_LDB(B0, 1, 0); PG8_SCHED; PG8_LDA(At, 1, 0); PG8_STAGE(PG8_SA(0, 1), a2 + hstepA, voffA);
            PG8_WAIT_L(8); PG8_BAR; PG8_WAIT_L(0); PG8_MMA(0, 0, At, B0); PG8_BAR; PG8_SCHED;
            PG8_LDB(B1, 1, 1); PG8_STAGE(PG8_SB(1, 0), b3, voffB);
            PG8_BAR; PG8_WAIT_L(0); PG8_MMA(0, 1, At, B1); PG8_BAR;
            PG8_LDA(At, 1, 1); PG8_STAGE(PG8_SA(1, 0), a3, voffA);
            PG8_BAR; PG8_WAIT_L(0); PG8_MMA(1, 0, At, B0); PG8_BAR; PG8_SCHED;
            PG8_STAGE(PG8_SB(1, 1), b3 + hstepB, voffB);
            PG8_WAIT_V(6); PG8_BAR; PG8_MMA(1, 1, At, B1); PG8_BAR;
        }
        E(acc, cur, wr, wc, fr, fq);
        if (!has_next) break;
#pragma unroll
        for (int a = 0; a < 2; ++a)
#pragma unroll
            for (int b = 0; b < 2; ++b)
#pragma unroll
                for (int m = 0; m < 4; ++m)
#pragma unroll
                    for (int n = 0; n < 2; ++n) acc[a][b][m][n] = (f32x4){0.f, 0.f, 0.f, 0.f};
        cur = nxt; cA = nA; cB = nB; ++ui;
    }
    PG8_WAIT_V(0);
    if (wr == 0) PG8_BAR;
    PG8_BAR;
#undef PG8_SA
#undef PG8_SB
#undef PG8_STAGE
#undef PG8_LDA
#undef PG8_LDB
#undef PG8_MMA
#undef PG8_WAIT_V
#undef PG8_WAIT_L
#undef PG8_BAR
#undef PG8_SCHED
}
}

template <int MAP> __device__ __forceinline__ int map_col(int n) {
    if (MAP == 0) return n;
    if (MAP == 1) return n < 6144 ? n : (n < 8256 ? n + 8 : (n < 8264 ? n - 2112 : -1));
    const int T = n >> 8, w = n & 255; return w < 128 ? 128 * T + w : DFF + 128 * T + (w - 128);
}
template <int MAP> __device__ __forceinline__ void cvt_matrix(const float* W, int K, int Nsrc, bf16_t* WT, int Ndst, LAS float* scr, int lane, int gw, int NGW) {
    const int nblk = Ndst / 32, nitems = (K / 64) * nblk;
    for (int item = gw; item < nitems; item += NGW) {
        const int kb = item / nblk, nb = item % nblk, k0 = 64 * kb, n0 = 32 * nb;
        const int src = map_col<MAP>(n0 + (lane & 31));
        const float* wp = W + (size_t)(k0 + (lane >> 5)) * Nsrc + (src >= 0 ? src : 0);
#pragma unroll 8
        for (int i = 0; i < 32; ++i) { const int kk = 2 * i + (lane >> 5); float v = wp[(size_t)(2 * i) * Nsrc]; if (src < 0) v = 0.f; scr[kk * 33 + (lane & 31)] = v; }
        LDS_WAIT();
        const int c = lane & 7;
#pragma unroll
        for (int j = 0; j < 4; ++j) { const int n = (lane >> 3) + 8 * j; const LAS float* s = scr + (8 * c) * 33 + n;
            u32x4 o; o.x = cvt_pk_bf16(s[0 * 33], s[1 * 33]); o.y = cvt_pk_bf16(s[2 * 33], s[3 * 33]); o.z = cvt_pk_bf16(s[4 * 33], s[5 * 33]); o.w = cvt_pk_bf16(s[6 * 33], s[7 * 33]);
            *(u32x4*)(WT + (size_t)(n0 + n) * K + k0 + 8 * c) = o; }
        LDS_WAIT();
    }
}

struct Ptrs {
    const float* in[17]; float* out; unsigned char* ws;
};
__device__ __forceinline__ bf16_t* w_ptr(unsigned char* ws, int l, int which) {
    size_t off = WS_W + (size_t)l * SZ_WL;
    if (which > 0) off += SZ_WIN; if (which > 1) off += SZ_WUQ; if (which > 2) off += SZ_WUKV; if (which > 3) off += SZ_WOUT; if (which > 4) off += SZ_WGU;
    return (bf16_t*)(ws + off);
}

__device__ __forceinline__ void p_prologue(const Ptrs& P, LAS unsigned char* lds, int gw, int NGW, int wave, int lane) {
    lane = opaque(lane); gw = opaque(gw);
    LAS float* scr = (LAS float*)(lds + wave * 8704);
    for (int l = 0; l < 2; ++l) {
        cvt_matrix<1>(P.in[3] + (size_t)l * DM * NIN_SRC, DM, NIN_SRC, w_ptr(P.ws, l, 0), NIN, scr, lane, gw, NGW);
        cvt_matrix<0>(P.in[8] + (size_t)l * QL * NQF, QL, NQF, w_ptr(P.ws, l, 1), NQF, scr, lane, gw, NGW);
        cvt_matrix<0>(P.in[10] + (size_t)l * KVL * NKVF, KVL, NKVF, w_ptr(P.ws, l, 2), NKVF, scr, lane, gw, NGW);
        cvt_matrix<0>(P.in[11] + (size_t)l * DM * DM, DM, DM, w_ptr(P.ws, l, 3), DM, scr, lane, gw, NGW);
        cvt_matrix<2>(P.in[14] + (size_t)l * DM * NGU, DM, NGU, w_ptr(P.ws, l, 4), NGU, scr, lane, gw, NGW);
        cvt_matrix<0>(P.in[15] + (size_t)l * DFF * DM, DFF, DM, w_ptr(P.ws, l, 5), DM, scr, lane, gw, NGW);
    }
    float* cosT = (float*)(P.ws + WS_COS); float* sinT = (float*)(P.ws + WS_SIN);
    for (int idx = gw * 64 + lane; idx < R * 32; idx += NGW * 64) {
        const int r = idx >> 5, i = idx & 31; const int pos = r >= RFIRST ? r - RFIRST : 0;
        const float invf = (float)pow(10000.0, -(double)i / 32.0);
        const float ang = (float)pos * invf;
        cosT[idx] = (float)cos((double)ang); sinT[idx] = (float)sin((double)ang);
    }
    float* hres = (float*)(P.ws + WS_HRES); bf16_t* u = (bf16_t*)(P.ws + WS_U);
    const float* g0 = P.in[2];
    for (int r = gw; r < R; r += NGW) {
        f32x4* hr = (f32x4*)(hres + (size_t)r * DM); u32x2* ur = (u32x2*)(u + (size_t)r * DM);
        if (r < RFIRST) {
#pragma unroll
            for (int j = 0; j < 16; ++j) { hr[64 * j + lane] = (f32x4){0.f, 0.f, 0.f, 0.f}; ur[64 * j + lane] = (u32x2){0u, 0u}; }
            continue;
        }
        const f32x4* src = (const f32x4*)(r < 256 ? P.in[1] + (size_t)(r - RFIRST) * DM : P.in[0] + (size_t)(r - 256) * DM);
        f32x4 v[16]; float ss = 0.f;
#pragma unroll
        for (int j = 0; j < 16; ++j) { v[j] = src[64 * j + lane]; ss += (v[j][0] * v[j][0] + v[j][1] * v[j][1]) + (v[j][2] * v[j][2] + v[j][3] * v[j][3]); }
        const float rs = 1.0f / sqrtf(wave_sum(ss) * (1.0f / DM) + EPS);
#pragma unroll
        for (int j = 0; j < 16; ++j) { hr[64 * j + lane] = v[j]; const f32x4 g = ((const f32x4*)g0)[64 * j + lane];
            ur[64 * j + lane] = (u32x2){cvt_pk_bf16(v[j][0] * rs * g[0], v[j][1] * rs * g[1]), cvt_pk_bf16(v[j][2] * rs * g[2], v[j][3] * rs * g[3])}; }
    }
}

__device__ __forceinline__ void p_resnorm(const bf16_t* y, float* hres, const float* gpost, const float* gnext, bf16_t* u, float* out, int gw, int NGW, int lane) {
    lane = opaque(lane); gw = opaque(gw);
    for (int r = gw; r < R; r += NGW) {
        if (r < RFIRST) continue;
        f32x4* hr = (f32x4*)(hres + (size_t)r * DM); const u32x2* yr = (const u32x2*)(y + (size_t)r * DM);
        f32x4 v[16]; float ss = 0.f;
#pragma unroll
        for (int j = 0; j < 16; ++j) { const u32x2 w = yr[64 * j + lane]; v[j] = (f32x4){bflo(w.x), bfhi(w.x), bflo(w.y), bfhi(w.y)};
            ss += (v[j][0] * v[j][0] + v[j][1] * v[j][1]) + (v[j][2] * v[j][2] + v[j][3] * v[j][3]); }
        const float rs = 1.0f / sqrtf(wave_sum(ss) * (1.0f / DM) + EPS);
        float ss2 = 0.f;
#pragma unroll
        for (int j = 0; j < 16; ++j) { const f32x4 g = ((const f32x4*)gpost)[64 * j + lane]; const f32x4 x = hr[64 * j + lane];
            v[j] = x + v[j] * rs * g; ss2 += (v[j][0] * v[j][0] + v[j][1] * v[j][1]) + (v[j][2] * v[j][2] + v[j][3] * v[j][3]); }
        if (out) {
            if (r >= 256) { f32x4* orow = (f32x4*)(out + (size_t)(r - 256) * DM);
#pragma unroll
                for (int j = 0; j < 16; ++j) orow[64 * j + lane] = v[j]; }
        } else {
            const float rs2 = 1.0f / sqrtf(wave_sum(ss2) * (1.0f / DM) + EPS);
            u32x2* ur = (u32x2*)(u + (size_t)r * DM);
#pragma unroll
            for (int j = 0; j < 16; ++j) { hr[64 * j + lane] = v[j]; const f32x4 g = ((const f32x4*)gnext)[64 * j + lane];
                ur[64 * j + lane] = (u32x2){cvt_pk_bf16(v[j][0] * rs2 * g[0], v[j][1] * rs2 * g[1]), cvt_pk_bf16(v[j][2] * rs2 * g[2], v[j][3] * rs2 * g[3])}; }
        }
    }
}

__device__ __forceinline__ void unpack8(const u32x4 w, float (&f)[8]) {
    f[0] = bflo(w.x); f[1] = bfhi(w.x); f[2] = bflo(w.y); f[3] = bfhi(w.y); f[4] = bflo(w.z); f[5] = bfhi(w.z); f[6] = bflo(w.w); f[7] = bfhi(w.w);
}
__device__ __forceinline__ u32x4 pack8f(const float (&f)[8]) { return (u32x4){cvt_pk_bf16(f[0], f[1]), cvt_pk_bf16(f[2], f[3]), cvt_pk_bf16(f[4], f[5]), cvt_pk_bf16(f[6], f[7])}; }

__device__ __forceinline__ void p_prep(const bf16_t* z, const float* convw, const float* bg, const float* gcq, const float* gckv, const float* cosT, const float* sinT,
                                       bf16_t* qc, bf16_t* kc, float* li, float* lf, bf16_t* cqn, bf16_t* ckvn, bf16_t* krr, int gw, int NGW, int lane) {
    lane = opaque(lane); gw = opaque(gw);
    for (int r = gw; r < R; r += NGW) {
        const bf16_t* zr = z + (size_t)r * NIN;
        if (r < RFIRST) {
            const unsigned zz = (unsigned)opaque(0); const u32x4 zero4 = (u32x4){zz, zz, zz, zz};
#pragma unroll
            for (int j = 0; j < 2; ++j) { *(u32x4*)(qc + (size_t)r * 1024 + 8 * (64 * j + lane)) = zero4; *(u32x4*)(kc + (size_t)r * 1024 + 8 * (64 * j + lane)) = zero4; }
#pragma unroll
            for (int j = 0; j < 3; ++j) *(u32x4*)(cqn + (size_t)r * QL + 8 * (64 * j + lane)) = zero4;
            *(u32x4*)(ckvn + (size_t)r * KVL + 8 * lane) = zero4;
            if (lane < 8) *(u32x4*)(krr + (size_t)r * 64 + 8 * lane) = zero4;
            if (lane < 4) { li[(size_t)r * 4 + lane] = -__builtin_inff(); lf[(size_t)r * 4 + lane] = 0.f; }
            continue;
        }
#pragma unroll
        for (int j = 0; j < 4; ++j) {
            const int c0 = 8 * (64 * j + lane);
            float a[8];
#pragma unroll
            for (int e = 0; e < 8; ++e) a[e] = 0.f;
#pragma unroll
            for (int tap = 0; tap < 4; ++tap) {
                const u32x4 xw = *(const u32x4*)(zr + (ptrdiff_t)(tap - 3) * NIN + c0); float x[8]; unpack8(xw, x);
                const f32x4 w0 = *(const f32x4*)(convw + tap * 2048 + c0), w1 = *(const f32x4*)(convw + tap * 2048 + c0 + 4);
                a[0] += w0[0] * x[0]; a[1] += w0[1] * x[1]; a[2] += w0[2] * x[2]; a[3] += w0[3] * x[3];
                a[4] += w1[0] * x[4]; a[5] += w1[1] * x[5]; a[6] += w1[2] * x[6]; a[7] += w1[3] * x[7];
            }
            const float sc = (c0 < 1024) ? 0.0625f : 1.0f;
#pragma unroll
            for (int e = 0; e < 8; ++e) a[e] = a[e] / (1.0f + __expf(-a[e])) * sc;
            bf16_t* dst = (c0 < 1024) ? qc + (size_t)r * 1024 + c0 : kc + (size_t)r * 1024 + (c0 - 1024);
            *(u32x4*)dst = pack8f(a);
        }
        if (lane < 8) { const float val = bf2f(zr[ZGI + lane]) + bg[lane];
            if (lane < 4) li[(size_t)r * 4 + lane] = val;
            else lf[(size_t)r * 4 + (lane - 4)] = fminf(val, 0.f) - log1pf(__expf(-fabsf(val))); }
        { float x[3][8]; float ss = 0.f;
#pragma unroll
          for (int j = 0; j < 3; ++j) { unpack8(*(const u32x4*)(zr + ZCQ + 8 * (64 * j + lane)), x[j]);
#pragma unroll
              for (int e = 0; e < 8; ++e) ss += x[j][e] * x[j][e]; }
          const float rs = 1.0f / sqrtf(wave_sum(ss) * (1.0f / QL) + EPS);
#pragma unroll
          for (int j = 0; j < 3; ++j) { const int c0 = 8 * (64 * j + lane); const f32x4 g0 = *(const f32x4*)(gcq + c0), g1 = *(const f32x4*)(gcq + c0 + 4);
              float o[8] = {x[j][0] * rs * g0[0], x[j][1] * rs * g0[1], x[j][2] * rs * g0[2], x[j][3] * rs * g0[3], x[j][4] * rs * g1[0], x[j][5] * rs * g1[1], x[j][6] * rs * g1[2], x[j][7] * rs * g1[3]};
              *(u32x4*)(cqn + (size_t)r * QL + c0) = pack8f(o); } }
        { float x[8]; unpack8(*(const u32x4*)(zr + ZCKV + 8 * lane), x); float ss = 0.f;
#pragma unroll
          for (int e = 0; e < 8; ++e) ss += x[e] * x[e];
          const float rs = 1.0f / sqrtf(wave_sum(ss) * (1.0f / KVL) + EPS);
          const f32x4 g0 = *(const f32x4*)(gckv + 8 * lane), g1 = *(const f32x4*)(gckv + 8 * lane + 4);
          float o[8] = {x[0] * rs * g0[0], x[1] * rs * g0[1], x[2] * rs * g0[2], x[3] * rs * g0[3], x[4] * rs * g1[0], x[5] * rs * g1[1], x[6] * rs * g1[2], x[7] * rs * g1[3]};
          *(u32x4*)(ckvn + (size_t)r * KVL + 8 * lane) = pack8f(o); }
        if (lane < 32) { const float x1 = bf2f(zr[ZKR + lane]), x2 = bf2f(zr[ZKR + 32 + lane]); const float c = cosT[(size_t)r * 32 + lane], s = sinT[(size_t)r * 32 + lane];
            krr[(size_t)r * 64 + lane] = f2bf(x1 * c - x2 * s); krr[(size_t)r * 64 + 32 + lane] = f2bf(x1 * s + x2 * c); }
    }
}

__device__ __forceinline__ void p_hcat(const float* hm, const bf16_t* z, const float* gmn, bf16_t* hcat, int gw, int NGW, int lane) {
    lane = opaque(lane); gw = opaque(gw);
    for (int r = gw; r < R; r += NGW) {
        if (r < RFIRST) {
            const unsigned zz = (unsigned)opaque(0); const u32x4 zero4 = (u32x4){zz, zz, zz, zz};
#pragma unroll
            for (int j = 0; j < 8; ++j) *(u32x4*)(hcat + (size_t)r * DM + 8 * (64 * j + lane)) = zero4;
            continue;
        }
#pragma unroll
        for (int h = 0; h < 4; ++h) {
            const int c0 = h * 512 + 8 * lane;
            const f32x4 a = *(const f32x4*)(hm + (size_t)r * 2048 + c0), b = *(const f32x4*)(hm + (size_t)r * 2048 + c0 + 4);
            const float ss = (a[0] * a[0] + a[1] * a[1]) + (a[2] * a[2] + a[3] * a[3]) + (b[0] * b[0] + b[1] * b[1]) + (b[2] * b[2] + b[3] * b[3]);
            const float rs = 1.0f / sqrtf(wave_sum(ss) * (1.0f / 512.0f) + EPS);
            float o[8]; unpack8(*(const u32x4*)(z + (size_t)r * NIN + ZO + c0), o);
            const f32x4 g0 = *(const f32x4*)(gmn + c0), g1 = *(const f32x4*)(gmn + c0 + 4);
            const float hv[8] = {a[0], a[1], a[2], a[3], b[0], b[1], b[2], b[3]}; const float gv[8] = {g0[0], g0[1], g0[2], g0[3], g1[0], g1[1], g1[2], g1[3]};
            float res[8];
#pragma unroll
            for (int e = 0; e < 8; ++e) res[e] = hv[e] * rs * gv[e] / (1.0f + __expf(-o[e]));
            *(u32x4*)(hcat + (size_t)r * DM + c0) = pack8f(res);
        }
    }
}

namespace att {
constexpr float SCALE = 0.07216878364870323f;
constexpr float THR = 8.f;
constexpr int KVBLK = 64, SHM_V = 64 * 128 * 2, SHM_K = 64 * 192 * 2;
constexpr int OFF_V = 0, OFF_K = 2 * SHM_V, OFF_WS = OFF_K + 2 * SHM_K;
__device__ __forceinline__ int v_st(int k, int c) { const int kk = (k & ~0xC) | ((k & 4) << 1) | ((k & 8) >> 1); return ((kk >> 3) * 4 + (c >> 5)) * 512 + ((kk & 7) * 32 + (c & 31)) * 2; }
__device__ __forceinline__ int v_rd_base(int lane) { return ((lane & 3) << 3) | (((lane >> 2) & 3) << 6) | (((lane >> 4) & 1) << 5) | (((lane >> 5) & 1) << 8); }
constexpr int v_rd_off(int d0, int ks, int half) { return d0 * 512 + ks * 4096 + half * 2048; }
__device__ __forceinline__ int crow(int r, int hi) { return (r & 3) + 8 * (r >> 2) + 4 * hi; }
__device__ __forceinline__ int k_off(int row, int ch) { return row * 384 + (((ch & ~7) | ((ch & 7) ^ ((row >> 1) & 7))) << 4); }

__device__ __forceinline__ void partialSM(f32x16& p0, f32x16& p1, float& m_reg, float& mn, float& alpha) {
    float pmax = p0[0];
#pragma unroll
    for (int r = 1; r < 16; ++r) pmax = fmaxf(pmax, p0[r]);
#pragma unroll
    for (int r = 0; r < 16; ++r) pmax = fmaxf(pmax, p1[r]);
    { auto rr = __builtin_amdgcn_permlane32_swap(__float_as_uint(pmax), __float_as_uint(pmax), false, false);
      pmax = fmaxf(__uint_as_float(rr[0]), __uint_as_float(rr[1])); }
    constexpr float C2 = 1.4426950408889634f * SCALE;
    if (__builtin_expect(__all((pmax - m_reg) * SCALE <= THR), 1)) { mn = m_reg; alpha = 1.f; }
    else { mn = fmaxf(m_reg, pmax); alpha = __builtin_amdgcn_exp2f((m_reg - mn) * C2); m_reg = mn; }
    const float mnL = -mn * C2;
#pragma unroll
    for (int r = 0; r < 16; ++r) p0[r] = fmaf(p0[r], C2, mnL);
#pragma unroll
    for (int r = 0; r < 16; ++r) p1[r] = fmaf(p1[r], C2, mnL);
#pragma unroll
    for (int r = 0; r < 16; ++r) p0[r] = __builtin_amdgcn_exp2f(p0[r]);
}
__device__ __forceinline__ void finishSM(f32x16& p0, f32x16& p1, float alpha, float& l_reg, bf16x8& pa0, bf16x8& pa1, bf16x8& pa2, bf16x8& pa3) {
#pragma unroll
    for (int r = 0; r < 16; ++r) p1[r] = __builtin_amdgcn_exp2f(p1[r]);
    float ps = 0;
#pragma unroll
    for (int r = 0; r < 16; ++r) ps += p0[r];
#pragma unroll
    for (int r = 0; r < 16; ++r) ps += p1[r];
    { auto rr = __builtin_amdgcn_permlane32_swap(__float_as_uint(ps), __float_as_uint(ps), false, false);
      ps = __uint_as_float(rr[0]) + __uint_as_float(rr[1]); }
    l_reg = l_reg * alpha + ps;
#define PK4(P, B_, OUT) do { unsigned a0 = cvt_pk_bf16(P[B_+0], P[B_+1]), a1 = cvt_pk_bf16(P[B_+2], P[B_+3]);                          \
        unsigned b0 = cvt_pk_bf16(P[B_+4], P[B_+5]), b1 = cvt_pk_bf16(P[B_+6], P[B_+7]);                                             \
        auto r0 = __builtin_amdgcn_permlane32_swap(a0, b0, false, false); auto r1 = __builtin_amdgcn_permlane32_swap(a1, b1, false, false); \
        u32x4 w = {r0[0], r1[0], r0[1], r1[1]}; OUT = *reinterpret_cast<bf16x8*>(&w); } while (0)
    PK4(p0, 0, pa0); PK4(p0, 8, pa1); PK4(p1, 0, pa2); PK4(p1, 8, pa3);
#undef PK4
}
template <int KB>
__device__ __forceinline__ void qkt(f32x16& p0, f32x16& p1, LAS const char* K_lds, int r32, int hi, const bf16x8* qr) {
    p0 = f32x16{}; p1 = f32x16{};
    LAS const char* kb[4];
#pragma unroll
    for (int dd = 0; dd < 4; ++dd) kb[dd] = K_lds + KB * SHM_K + k_off(r32, dd * 2 + hi);
#pragma unroll
    for (int d0 = 0; d0 < 12; ++d0) { LAS const char* a = kb[d0 & 3] + (d0 >> 2) * 128;
        const bf16x8 b0 = *reinterpret_cast<LAS const bf16x8*>(a);
        const bf16x8 b1 = *reinterpret_cast<LAS const bf16x8*>(a + 32 * 384);
        p0 = __builtin_amdgcn_mfma_f32_32x32x16_bf16(b0, qr[d0], p0, 0, 0, 0);
        p1 = __builtin_amdgcn_mfma_f32_32x32x16_bf16(b1, qr[d0], p1, 0, 0, 0); }
}
template <int VB>
__device__ __forceinline__ void pv_tile(f32x16* o, unsigned vb0, bf16x8 pa0, bf16x8 pa1, bf16x8 pa2, bf16x8 pa3) {
#define TRRD(dst, off) asm volatile("ds_read_b64_tr_b16 %0, %1 offset:%2" : "=&v"(dst) : "v"(vb0), "i"(off) : "memory")
#define PV_D0(d0) do { s16x4 l0, l1, l2, l3, h0, h1, h2, h3; constexpr int b_ = VB * SHM_V + v_rd_off(d0, 0, 0); \
        TRRD(l0, b_); TRRD(h0, b_ + 2048); TRRD(l1, b_ + 4096); TRRD(h1, b_ + 6144); TRRD(l2, b_ + 8192); TRRD(h2, b_ + 10240); TRRD(l3, b_ + 12288); TRRD(h3, b_ + 14336); \
        asm volatile("s_waitcnt lgkmcnt(0)" ::: "memory"); SBAR();   \
        o[d0] = __builtin_amdgcn_mfma_f32_32x32x16_bf16(pa0, (bf16x8){l0[0], l0[1], l0[2], l0[3], h0[0], h0[1], h0[2], h0[3]}, o[d0], 0, 0, 0);   \
        o[d0] = __builtin_amdgcn_mfma_f32_32x32x16_bf16(pa1, (bf16x8){l1[0], l1[1], l1[2], l1[3], h1[0], h1[1], h1[2], h1[3]}, o[d0], 0, 0, 0);   \
        o[d0] = __builtin_amdgcn_mfma_f32_32x32x16_bf16(pa2, (bf16x8){l2[0], l2[1], l2[2], l2[3], h2[0], h2[1], h2[2], h2[3]}, o[d0], 0, 0, 0);   \
        o[d0] = __builtin_amdgcn_mfma_f32_32x32x16_bf16(pa3, (bf16x8){l3[0], l3[1], l3[2], l3[3], h3[0], h3[1], h3[2], h3[3]}, o[d0], 0, 0, 0); } while (0)
    PV_D0(0); PV_D0(1); PV_D0(2); PV_D0(3);
#undef PV_D0
#undef TRRD
}

__device__ __forceinline__ void attn_unit(LAS char* lds, int head, int qb, const bf16_t* qf, const bf16_t* kvf, const bf16_t* krr,
                                          const float* cosT, const float* sinT, bf16_t* hcat) {
    const int tid = opaque(threadIdx.x), wid = __builtin_amdgcn_readfirstlane(tid >> 6), lane = tid & 63, r32 = lane & 31, hi = lane >> 5;
    const int row_w0 = qb * 256 + wid * 32, qrow = row_w0 + r32;
    LAS char* V_lds = lds + OFF_V; LAS char* K_lds = lds + OFF_K;
    LAS float* wsf = (LAS float*)(lds + OFF_WS) + wid * 64; LAS float* li_l = wsf; LAS float* al_l = wsf + 32;
    bf16x8 qr[12];
    { const bf16_t* qp = qf + (size_t)qrow * NQF + head * 192 + hi * 8;
#pragma unroll
      for (int d0 = 0; d0 < 12; ++d0) qr[d0] = *(const bf16x8*)(qp + d0 * 16);
#pragma unroll
      for (int pp = 0; pp < 2; ++pp) {
          const int i0 = pp * 16 + hi * 8;
          const f32x4 c0 = *(const f32x4*)(cosT + (size_t)qrow * 32 + i0), c1 = *(const f32x4*)(cosT + (size_t)qrow * 32 + i0 + 4);
          const f32x4 s0 = *(const f32x4*)(sinT + (size_t)qrow * 32 + i0), s1 = *(const f32x4*)(sinT + (size_t)qrow * 32 + i0 + 4);
          const float cc[8] = {c0[0], c0[1], c0[2], c0[3], c1[0], c1[1], c1[2], c1[3]}, sn[8] = {s0[0], s0[1], s0[2], s0[3], s1[0], s1[1], s1[2], s1[3]};
          float x1[8], x2[8], y1[8], y2[8];
          unpack8(*reinterpret_cast<u32x4*>(&qr[8 + pp]), x1); unpack8(*reinterpret_cast<u32x4*>(&qr[10 + pp]), x2);
#pragma unroll
          for (int e = 0; e < 8; ++e) { y1[e] = x1[e] * cc[e] - x2[e] * sn[e]; y2[e] = x1[e] * sn[e] + x2[e] * cc[e]; }
          u32x4 w1 = pack8f(y1), w2 = pack8f(y2);
          qr[8 + pp] = *reinterpret_cast<bf16x8*>(&w1); qr[10 + pp] = *reinterpret_cast<bf16x8*>(&w2);
      } }
    const int NT = 4 * qb + 1;
    float m_reg = -1e30f, l_reg = 0; f32x16 o[4] = {};
    const int krow = tid >> 3, kc8 = tid & 7;
    const int kwr = krow * 384 + ((kc8 ^ ((krow >> 1) & 7)) << 4);
    const int sr = tid >> 4, sc = (tid & 15) * 8;
    const int vst0 = v_st(sr, sc), vst1 = v_st(32 + sr, sc);
    const unsigned vb0 = (unsigned)(uintptr_t)V_lds + (unsigned)v_rd_base(lane);
    bf16x8 sk[3], sv[2];
#define LOADT(t) do { const int kb_ = (3 + (t)) * KVBLK; const bf16_t* kp_ = kvf + (size_t)(kb_ + krow) * NKVF + head * 256 + kc8 * 8; \
        sk[0] = *(const bf16x8*)kp_; sk[1] = *(const bf16x8*)(kp_ + 64); sk[2] = *(const bf16x8*)(krr + (size_t)(kb_ + krow) * 64 + kc8 * 8); \
        sv[0] = *(const bf16x8*)(kvf + (size_t)(kb_ + sr) * NKVF + head * 256 + 128 + sc); sv[1] = *(const bf16x8*)(kvf + (size_t)(kb_ + 32 + sr) * NKVF + head * 256 + 128 + sc); } while (0)
#define WRITET(bf) do { _Pragma("unroll") for (int i = 0; i < 3; ++i) *(LAS bf16x8*)(K_lds + (bf) * SHM_K + kwr + 128 * i) = sk[i]; \
        *(LAS bf16x8*)(V_lds + (bf) * SHM_V + vst0) = sv[0]; *(LAS bf16x8*)(V_lds + (bf) * SHM_V + vst1) = sv[1]; } while (0)
#define RESC(a) do { if (__any((a) < 1.f)) { if (hi == 0) al_l[r32] = (a); asm volatile("s_waitcnt lgkmcnt(0)" ::: "memory");              \
                     _Pragma("unroll") for (int d_ = 0; d_ < 4; ++d_) _Pragma("unroll") for (int r = 0; r < 16; ++r) o[d_][r] *= al_l[crow(r, hi)]; } } while (0)
#define STEP(t, BUF) do { \
        if ((t) + 1 < NT) LOADT((t) + 1); \
        f32x16 p0, p1; float mn, alpha; bf16x8 pa0, pa1, pa2, pa3; \
        qkt<BUF>(p0, p1, K_lds, r32, hi, qr); \
        { const int kb_ = (3 + (t)) * KVBLK; \
          if (kb_ + KVBLK - 1 > row_w0 || kb_ < RFIRST) { const float NEG = -__builtin_inff(); \
            _Pragma("unroll") for (int r = 0; r < 16; ++r) { const int key0 = kb_ + crow(r, hi); \
                if (key0 > qrow || key0 < RFIRST) p0[r] = NEG; if (key0 + 32 > qrow || key0 + 32 < RFIRST) p1[r] = NEG; } } } \
        partialSM(p0, p1, m_reg, mn, alpha); \
        RESC(alpha); \
        finishSM(p0, p1, alpha, l_reg, pa0, pa1, pa2, pa3); SBAR(); \
        pv_tile<BUF>(o, vb0, pa0, pa1, pa2, pa3); \
        if ((t) + 1 < NT) WRITET((BUF) ^ 1); \
        __syncthreads(); } while (0)
    LOADT(0); WRITET(0); __syncthreads();
    for (int t = 0; t < NT; t += 2) {
        STEP(t, 0);
        if (t + 1 < NT) STEP(t + 1, 1);
    }
    if (hi == 0) li_l[r32] = l_reg; asm volatile("s_waitcnt lgkmcnt(0)" ::: "memory");
    float rli[16];
#pragma unroll
    for (int r = 0; r < 16; ++r) rli[r] = __builtin_amdgcn_rcpf(li_l[crow(r, hi)]);
    bf16_t* Ow = hcat + (size_t)row_w0 * DM + 2048 + head * 128;
#pragma unroll
    for (int r = 0; r < 16; ++r) { const int orow = crow(r, hi);
#pragma unroll
        for (int d0 = 0; d0 < 4; ++d0) { const float v = o[d0][r] * rli[r]; const float vn = __shfl_xor(v, 1);
            if ((r32 & 1) == 0 && row_w0 + orow >= RFIRST) *(unsigned*)(Ow + (size_t)orow * DM + d0 * 32 + r32) = cvt_pk_bf16(v, vn); } }
#undef LOADT
#undef WRITET
#undef RESC
#undef STEP
}
}

namespace mls {
constexpr int QP = 528, VP = 272, SP = 144;
constexpr int Q_OFF = 0, K_OFF = 33792, V_OFF = 67584, S_OFF = 84992, SC_OFF = 94208, DEN_OFF = 110592, N_OFF = 110848, GC_OFF = 112896;
__device__ __forceinline__ f32x4 mfma16(bf16x8 a, bf16x8 b, f32x4 c) { return __builtin_amdgcn_mfma_f32_16x16x32_bf16(a, b, c, 0, 0, 0); }
#define TR64(dst, addr, off) asm volatile("ds_read_b64_tr_b16 %0, %1 offset:%2" : "=&v"(dst) : "v"(addr), "i"(off) : "memory")

__device__ __forceinline__ void mlstm_unit(LAS unsigned char* lds, int h, int sl, int grp, int so, const bf16_t* qc, const bf16_t* kc, const bf16_t* z, const float* li, const float* lf, float* hm, float* cst, float* nst, unsigned* p1cnt, unsigned* tmo) {
    const int tid = opaque(threadIdx.x), wave = __builtin_amdgcn_readfirstlane(tid >> 6), lane = tid & 63, n16 = lane & 15, g = lane >> 4;
    const int tq = (lane >> 2) & 3, tp = lane & 3;
    const unsigned lbase = (unsigned)(uintptr_t)lds;
    LAS float* sc_u = (LAS float*)(lds + SC_OFF + wave * 2048); LAS float* sc_vv = sc_u + 64; LAS float* sc_wi = sc_u + 128; LAS float* sc_fl = sc_u + 192; LAS float* sc_ew = sc_u + 256;
    LAS float* den_l = (LAS float*)(lds + DEN_OFF); LAS float* nbuf = (LAS float*)(lds + N_OFF);
    const int dvb = sl * 128 + wave * 16;
    f32x4 Cacc[16];
#pragma unroll
    for (int i = 0; i < 16; ++i) Cacc[i] = (f32x4){0.f, 0.f, 0.f, 0.f};
    float m_c = 0.f;
    nbuf[tid] = 0.f;
    const int u16 = h * 4 + sl;
    const int c_beg = grp == 0 ? 3 : (grp == 1 ? 67 : (grp == 2 ? 131 : 195)), c_end = grp == 0 ? 67 : (grp == 1 ? 131 : (grp == 2 ? 195 : NCHUNK));
    float coef0 = 0.f, coef1 = 0.f, coef2 = 0.f;
    if (grp > 0) {
        LAS float* gC = (LAS float*)(lds + GC_OFF); LAS float* vmC = gC + 264;
        for (int c = 3 + wave; c < c_beg; c += 8) {
            const float li_t = li[((size_t)c * 64 + lane) * 4 + h], lf_t = lf[((size_t)c * 64 + lane) * 4 + h];
            float b = lf_t;
#pragma unroll
            for (int o = 1; o < 64; o <<= 1) { const float t_ = __shfl_up(b, o); if (lane >= o) b += t_; }
            float vm = li_t - b;
#pragma unroll
            for (int o = 1; o < 64; o <<= 1) vm = fmaxf(vm, __shfl_xor(vm, o));
            if (lane == 63) { gC[c] = b; vmC[c] = vm; }
        }
        __syncthreads();
        float m = 0.f, mS1 = 0.f, mS2 = 0.f, mS3 = 0.f, G1 = 0.f, G2 = 0.f;
        for (int c = 3; c < c_beg; ++c) { const float gg = gC[c]; m = fmaxf(gg + m, gg + vmC[c]);
            if (c >= 67 && c < 131) G1 += gg; if (c >= 131 && c < 195) G2 += gg;
            if (c == 66) mS1 = m; if (c == 130) mS2 = m; if (c == 194) mS3 = m; }
        m_c = m;
        const float P1 = fexp(G1 + mS1 - mS2), P2 = fexp(G2 + mS2 - mS3);
        if (grp == 1) { coef0 = 1.f; }
        else if (grp == 2) { coef0 = P1; coef1 = 1.f; }
        else { coef0 = P2 * P1; coef1 = P2; coef2 = 1.f; }
    }
    bf16x8 sq[4], sk[4], sv[2]; float pli, plf;
    const int srow = tid >> 5, sch = tid & 31, vrow0 = tid >> 4, vch = tid & 15;
    const bf16_t* gq = qc + (size_t)srow * 1024 + h * 256 + sch * 8; const bf16_t* gk = kc + (size_t)srow * 1024 + h * 256 + sch * 8;
    const bf16_t* gv = z + (size_t)vrow0 * NIN + ZV + h * 512 + sl * 128 + vch * 8;
    LAS unsigned char* wq = lds + Q_OFF + srow * QP + sch * 16; LAS unsigned char* wv = lds + V_OFF + vrow0 * VP + vch * 16;
#define ML_LOAD(c) do { const size_t r0_ = (size_t)(c) * 64; \
        _Pragma("unroll") for (int i = 0; i < 4; ++i) { sq[i] = *(const bf16x8*)(gq + (r0_ + 16 * i) * 1024); sk[i] = *(const bf16x8*)(gk + (r0_ + 16 * i) * 1024); } \
        sv[0] = *(const bf16x8*)(gv + r0_ * NIN); sv[1] = *(const bf16x8*)(gv + (r0_ + 32) * NIN); pli = li[(r0_ + lane) * 4 + h]; plf = lf[(r0_ + lane) * 4 + h]; } while (0)
#define ML_WRITE() do { _Pragma("unroll") for (int i = 0; i < 4; ++i) { *(LAS bf16x8*)(wq + i * 16 * QP) = sq[i]; *(LAS bf16x8*)(wq + (K_OFF - Q_OFF) + i * 16 * QP) = sk[i]; } \
        *(LAS bf16x8*)(wv) = sv[0]; *(LAS bf16x8*)(wv + 32 * VP) = sv[1]; } while (0)
    LAS const unsigned char* qrow_b = lds + Q_OFF + n16 * QP + g * 16;
    LAS const unsigned char* qsub_b = lds + Q_OFF + n16 * QP + (g >> 1) * 16 + (g & 1) * 8;
    LAS const unsigned char* srow_b = lds + S_OFF + n16 * SP + g * 16;
    const unsigned ktr_b = lbase + K_OFF + (8 * g + tq) * QP + (tp >> 1) * 16 + (tp & 1) * 8;
    const unsigned vtr_b = lbase + V_OFF + (8 * g + tq) * VP + (2 * wave + (tp >> 1)) * 16 + (tp & 1) * 8;
    if (!so && grp > 0) {
        if (tid == 0) { unsigned sp = 0;
            while (__hip_atomic_load(p1cnt, __ATOMIC_RELAXED, __HIP_MEMORY_SCOPE_AGENT) < 48u) { __builtin_amdgcn_s_sleep(8);
                if ((++sp & 255u) == 0u) { if (__hip_atomic_load(tmo, __ATOMIC_RELAXED, __HIP_MEMORY_SCOPE_AGENT)) break; if (sp > (1u << 22)) { atomicAdd(tmo, 1u); break; } } }
            __builtin_amdgcn_fence(__ATOMIC_ACQUIRE, "agent");
            asm volatile("s_waitcnt vmcnt(0)" ::: "memory"); }
        __syncthreads();
        float nacc = 0.f;
#pragma unroll
        for (int gp = 0; gp < 3; ++gp) { const float cf = gp == 0 ? coef0 : (gp == 1 ? coef1 : coef2);
            if (gp < grp) { const f32x4* src = (const f32x4*)(cst + (((size_t)gp * 16 + u16) * 512 + tid) * 64);
#pragma unroll
                for (int i = 0; i < 16; ++i) Cacc[i] += cf * src[i];
                if (tid < 256) nacc += cf * nst[((size_t)gp * 16 + u16) * 256 + tid]; } }
        if (tid < 256) nbuf[(c_beg & 1) * 256 + tid] = nacc;
    }
    ML_LOAD(c_beg); ML_WRITE(); __syncthreads();
    for (int c = c_beg; c < c_end; ++c) {
        const float li_t = pli, lf_t = plf;
        if (c + 1 < c_end) ML_LOAD(c + 1);
        const size_t r0 = (size_t)c * 64;
        float b = lf_t;
#pragma unroll
        for (int o = 1; o < 64; o <<= 1) { const float t_ = __shfl_up(b, o); if (lane >= o) b += t_; }
        const float vv = li_t - b;
        float pm = vv;
#pragma unroll
        for (int o = 1; o < 64; o <<= 1) { const float t_ = __shfl_up(pm, o); if (lane >= o) pm = fmaxf(pm, t_); }
        const float gl = __shfl(b, 63), vvmax = __shfl(pm, 63);
        const float mt_ = fmaxf(b + m_c, b + pm);
        const float u_t = b - mt_;
        const float m_next = fmaxf(gl + m_c, gl + vvmax);
        const float decay = fexp(gl + m_c - m_next);
        sc_u[lane] = u_t; sc_vv[lane] = vv; sc_wi[lane] = fexp(u_t + m_c); sc_fl[lane] = fexp(-mt_); sc_ew[lane] = fexp(gl + vv - m_next);
        LDS_WAIT();
        f32x4 acc[4];
        if (!so) {
        {
            const int tT = wave >> 1, sT0 = 2 * (wave & 1);
            f32x4 s0 = (f32x4){0.f, 0.f, 0.f, 0.f}, s1 = s0;
            if (sT0 <= tT) {
                LAS const unsigned char* ab = qrow_b + tT * 16 * QP; LAS const unsigned char* bb = qrow_b + (K_OFF - Q_OFF) + sT0 * 16 * QP;
#pragma unroll
                for (int ks = 0; ks < 8; ++ks) {
                    const bf16x8 a = *(const LAS bf16x8*)(ab + ks * 64);
                    const bf16x8 b0 = *(const LAS bf16x8*)(bb + ks * 64);
                    const bf16x8 b1 = *(const LAS bf16x8*)(bb + 16 * QP + ks * 64);
                    s0 = mfma16(a, b0, s0); s1 = mfma16(a, b1, s1);
                }
            }
#pragma unroll
            for (int jj = 0; jj < 2; ++jj) {
                const int s_ = 16 * (sT0 + jj) + n16; const float vvs = sc_vv[s_];
#pragma unroll
                for (int i = 0; i < 4; ++i) { const int t_ = 16 * tT + 4 * g + i;
                    const float sv_ = (jj == 0 ? s0[i] : s1[i]);
                    const float val = (s_ <= t_) ? sv_ * fexp(sc_u[t_] + vvs) : 0.f;
                    *(LAS unsigned short*)(lds + S_OFF + t_ * SP + s_ * 2) = f2bf(val); }
            }
        }
#pragma unroll
        for (int mt = 0; mt < 4; ++mt) acc[mt] = (f32x4){0.f, 0.f, 0.f, 0.f};
#pragma unroll
        for (int i = 0; i < 8; ++i) {
            u32x4 bw; bw.x = cvt_pk_bf16(Cacc[2 * i][0], Cacc[2 * i][1]); bw.y = cvt_pk_bf16(Cacc[2 * i][2], Cacc[2 * i][3]);
            bw.z = cvt_pk_bf16(Cacc[2 * i + 1][0], Cacc[2 * i + 1][1]); bw.w = cvt_pk_bf16(Cacc[2 * i + 1][2], Cacc[2 * i + 1][3]);
            const bf16x8 bfr = *reinterpret_cast<bf16x8*>(&bw);
#pragma unroll
            for (int mt = 0; mt < 4; ++mt) {
                const u32x2 lo = *(const LAS u32x2*)(qsub_b + mt * 16 * QP + i * 64);
                const u32x2 hi2 = *(const LAS u32x2*)(qsub_b + mt * 16 * QP + i * 64 + 32);
                u32x4 aw = (u32x4){lo.x, lo.y, hi2.x, hi2.y};
                acc[mt] = mfma16(*reinterpret_cast<bf16x8*>(&aw), bfr, acc[mt]); }
        }
#pragma unroll
        for (int mt = 0; mt < 4; ++mt)
#pragma unroll
            for (int i = 0; i < 4; ++i) acc[mt][i] *= sc_wi[16 * mt + 4 * g + i];
        __syncthreads();
        }
        LAS const float* ncur = nbuf + (c & 1) * 256; LAS float* nnext = nbuf + ((c + 1) & 1) * 256;
        if (!so) {
            const int t_ = 8 * wave + (lane >> 3), seg = lane & 7;
            float sv8[8]; unpack8(*(const LAS u32x4*)(lds + S_OFF + t_ * SP + seg * 16), sv8);
            float rsum = ((sv8[0] + sv8[1]) + (sv8[2] + sv8[3])) + ((sv8[4] + sv8[5]) + (sv8[6] + sv8[7]));
            float qn = 0.f;
#pragma unroll
            for (int cc = 0; cc < 4; ++cc) { float q8[8]; unpack8(*(const LAS u32x4*)(lds + Q_OFF + t_ * QP + (4 * seg + cc) * 16), q8);
                const f32x4 n0 = *(const LAS f32x4*)(ncur + 32 * seg + 8 * cc), n1 = *(const LAS f32x4*)(ncur + 32 * seg + 8 * cc + 4);
                qn += (q8[0] * n0[0] + q8[1] * n0[1]) + (q8[2] * n0[2] + q8[3] * n0[3]) + (q8[4] * n1[0] + q8[5] * n1[1]) + (q8[6] * n1[2] + q8[7] * n1[3]); }
            rsum += __shfl_xor(rsum, 1); rsum += __shfl_xor(rsum, 2); rsum += __shfl_xor(rsum, 4);
            qn += __shfl_xor(qn, 1); qn += __shfl_xor(qn, 2); qn += __shfl_xor(qn, 4);
            if (seg == 0) den_l[t_] = 1.0f / fmaxf(fabsf(sc_wi[t_] * qn + rsum), sc_fl[t_]);
        }
        if (tid < 256) { float nn = decay * ncur[tid]; LAS const unsigned char* kp = lds + K_OFF + tid * 2;
#pragma unroll 8
            for (int s_ = 0; s_ < 64; ++s_) nn += sc_ew[s_] * bf2f(*(const LAS unsigned short*)(kp + s_ * QP));
            nnext[tid] = nn; }
        bf16x8 vB[2];
        { s16x4 l0, h0, l1, h1;
          TR64(l0, vtr_b, 0); TR64(h0, vtr_b, 4 * VP); TR64(l1, vtr_b, 32 * VP); TR64(h1, vtr_b, 36 * VP); LDS_WAIT(); SBAR();
          vB[0] = (bf16x8){l0[0], l0[1], l0[2], l0[3], h0[0], h0[1], h0[2], h0[3]}; vB[1] = (bf16x8){l1[0], l1[1], l1[2], l1[3], h1[0], h1[1], h1[2], h1[3]}; }
        if (!so) {
#pragma unroll
        for (int ks = 0; ks < 2; ++ks)
#pragma unroll
            for (int mt = 0; mt < 4; ++mt) {
                const bf16x8 a = *(const LAS bf16x8*)(srow_b + mt * 16 * SP + ks * 64);
                acc[mt] = mfma16(a, vB[ks], acc[mt]); }
        __syncthreads();
        { float* hp = hm + (r0 + 4 * g) * 2048 + h * 512 + dvb + n16;
#pragma unroll
          for (int mt = 0; mt < 4; ++mt)
#pragma unroll
            for (int i = 0; i < 4; ++i) { const int t_ = 16 * mt + 4 * g + i;
                hp[(size_t)(16 * mt + i) * 2048] = acc[mt][i] * den_l[t_]; } }
        }
        bf16x8 vBs[2];
#pragma unroll
        for (int ks = 0; ks < 2; ++ks) { float f8[8]; unpack8(*reinterpret_cast<u32x4*>(&vB[ks]), f8);
#pragma unroll
            for (int j = 0; j < 8; ++j) f8[j] *= sc_ew[32 * ks + 8 * g + j];
            u32x4 w = pack8f(f8); vBs[ks] = *reinterpret_cast<bf16x8*>(&w); }
#pragma unroll
        for (int i = 0; i < 16; ++i) Cacc[i] *= decay;
#define ML_UPD(ks, ib) do { s16x4 l0, h0, l1, h1, l2, h2, l3, h3; constexpr int o_ = (ks) * 32 * QP + (ib) * 32; \
            TR64(l0, ktr_b, o_); TR64(h0, ktr_b, o_ + 4 * QP); TR64(l1, ktr_b, o_ + 32); TR64(h1, ktr_b, o_ + 32 + 4 * QP); \
            TR64(l2, ktr_b, o_ + 64); TR64(h2, ktr_b, o_ + 64 + 4 * QP); TR64(l3, ktr_b, o_ + 96); TR64(h3, ktr_b, o_ + 96 + 4 * QP); LDS_WAIT(); SBAR(); \
            Cacc[(ib) + 0] = mfma16((bf16x8){l0[0], l0[1], l0[2], l0[3], h0[0], h0[1], h0[2], h0[3]}, vBs[ks], Cacc[(ib) + 0]); \
            Cacc[(ib) + 1] = mfma16((bf16x8){l1[0], l1[1], l1[2], l1[3], h1[0], h1[1], h1[2], h1[3]}, vBs[ks], Cacc[(ib) + 1]); \
            Cacc[(ib) + 2] = mfma16((bf16x8){l2[0], l2[1], l2[2], l2[3], h2[0], h2[1], h2[2], h2[3]}, vBs[ks], Cacc[(ib) + 2]); \
            Cacc[(ib) + 3] = mfma16((bf16x8){l3[0], l3[1], l3[2], l3[3], h3[0], h3[1], h3[2], h3[3]}, vBs[ks], Cacc[(ib) + 3]); } while (0)
        ML_UPD(0, 0); ML_UPD(0, 4); ML_UPD(0, 8); ML_UPD(0, 12); ML_UPD(1, 0); ML_UPD(1, 4); ML_UPD(1, 8); ML_UPD(1, 12);
#undef ML_UPD
        m_c = m_next;
        __syncthreads();
        if (c + 1 < c_end) ML_WRITE();
        __syncthreads();
    }
    if (so) {
        f32x4* dst = (f32x4*)(cst + (((size_t)grp * 16 + u16) * 512 + tid) * 64);
#pragma unroll
        for (int i = 0; i < 16; ++i) dst[i] = Cacc[i];
        if (tid < 256) nst[((size_t)grp * 16 + u16) * 256 + tid] = nbuf[(c_end & 1) * 256 + tid];
        asm volatile("s_waitcnt vmcnt(0)" ::: "memory");
        __syncthreads();
        if (tid == 0) { __builtin_amdgcn_fence(__ATOMIC_RELEASE, "agent"); asm volatile("s_waitcnt vmcnt(0)" ::: "memory");
            __hip_atomic_fetch_add(p1cnt, 1u, __ATOMIC_RELAXED, __HIP_MEMORY_SCOPE_AGENT); }
    }
#undef ML_LOAD
#undef ML_WRITE
}
#undef TR64
}

constexpr int LDS_BYTES = 147456;
constexpr int MISC_OFF = 131072 + 4096;
constexpr int NPHASE = 21;
struct Args { Ptrs p; int ph_lo, ph_hi; };

__global__ void __launch_bounds__(512, 2) fwd_kernel(Args args) {
    extern __shared__ __attribute__((aligned(16))) unsigned char lds_raw[];
    LAS unsigned char* lds = (LAS unsigned char*)lds_raw;
    volatile LAS unsigned* MISC = (volatile LAS unsigned*)(lds + MISC_OFF);
    const int tid = threadIdx.x, lane = tid & 63, wave = __builtin_amdgcn_readfirstlane(tid >> 6);
    const int G = gridDim.x; const int bx = blockIdx.x;
    const int gw = bx * 8 + wave, NGW = G * 8;
    const Ptrs& P = args.p;
    unsigned char* ws = P.ws;
    unsigned* ctl = (unsigned*)(ws + WS_CTL);
    if (tid < 64) MISC[tid] = 0u;
    __syncthreads();
#if MK_PER_PHASE
    XcdBarrier bar; bar.bar = ctl + CW_BAR; bar.x = 0; bar.st = nullptr;
#define GRID_BAR() do { } while (0)
#else
    XcdBarrier bar = xcd_barrier_post(ctl + CW_BAR, MISC + 8);
#define GRID_BAR() xcd_barrier(bar)
#endif
    const int lo = args.ph_lo, hi = args.ph_hi;
#ifndef PH_MASK
#define PH_MASK 0xFFFF
#endif
#define PHON(t) (((PH_MASK) >> (t)) & 1)
#ifndef DUP_MASK
#define DUP_MASK 0
#endif
#define NREP(t) ((((DUP_MASK) >> (t)) & 1) ? 2 : 1)
#define IN(k) (lo <= (k) && (k) < hi)
#define BOTH(k) (IN(k) && IN((k) + 1))

    float* hres = (float*)(ws + WS_HRES); bf16_t* u = (bf16_t*)(ws + WS_U); bf16_t* z = (bf16_t*)(ws + WS_Z);
    bf16_t* qc = (bf16_t*)(ws + WS_QC); bf16_t* kc = (bf16_t*)(ws + WS_KC); bf16_t* cqn = (bf16_t*)(ws + WS_CQN); bf16_t* ckvn = (bf16_t*)(ws + WS_CKVN);
    bf16_t* krr = (bf16_t*)(ws + WS_KRR); bf16_t* qf = (bf16_t*)(ws + WS_QF); bf16_t* kvf = (bf16_t*)(ws + WS_KVF); float* hm = (float*)(ws + WS_HM);
    bf16_t* hcat = (bf16_t*)(ws + WS_HCAT); bf16_t* mix = z; bf16_t* act = z; bf16_t* yb = kvf;
    float* cosT = (float*)(ws + WS_COS); float* sinT = (float*)(ws + WS_SIN); float* li = (float*)(ws + WS_LI); float* lf = (float*)(ws + WS_LF);

    if (PHON(0) && IN(0)) { for (int rep = 0; rep < NREP(0); ++rep) { p_prologue(P, lds, gw, NGW, wave, lane); if (BOTH(0)) GRID_BAR(); } }

#pragma unroll 1
    for (int l = 0; l < 2; ++l) {
        const int pb = 1 + 10 * l;
        if (PHON(1) && IN(pb + 0)) { for (int rep = 0; rep < NREP(1); ++rep) {
            pg8::Gemm g{u, w_ptr(ws, l, 0), R, NIN, DM, DM, DM}; pg8::StaticOrder S; S.init(R, NIN, G, bx);
            pg8::EpiBf16 E{z, NIN};
            pg8::gemm_phase<pg8::EpiBf16>(lds, g, S, E);
            if (BOTH(pb + 0)) GRID_BAR();
        } }
        if (PHON(2) && IN(pb + 1)) { for (int rep = 0; rep < NREP(2); ++rep) {
            p_prep(z, P.in[4] + (size_t)l * 4 * 2048, P.in[5] + l * 8, P.in[7] + (size_t)l * QL, P.in[9] + (size_t)l * KVL, cosT, sinT, qc, kc, li, lf, cqn, ckvn, krr, gw, NGW, lane);
            if (BOTH(pb + 1)) GRID_BAR();
        } }
        if (PHON(3) && IN(pb + 2)) { for (int rep = 0; rep < NREP(3); ++rep) {
#pragma unroll 1
            for (int gi = 0; gi < 2; ++gi) {
                pg8::Gemm g{gi ? ckvn : cqn, w_ptr(ws, l, gi ? 2 : 1), R, gi ? NKVF : NQF, gi ? KVL : QL, gi ? KVL : QL, gi ? KVL : QL};
                pg8::StaticOrder S; S.init(R, g.N, G, bx);
                pg8::EpiBf16 E{gi ? kvf : qf, g.N}; pg8::gemm_phase<pg8::EpiBf16>(lds, g, S, E);
                __syncthreads();
            }
            if (BOTH(pb + 2)) GRID_BAR();
        } }
        if (PHON(4) && IN(pb + 3)) { for (int rep = 0; rep < NREP(4); ++rep) {
            unsigned* qhead = ctl + CW_Q + 64 * l + 1024 * rep;
            constexpr int NUNITS = 48 + 64 + NQB * 16;
            unsigned* p1cnt = ctl + CW_P1 + 64 * l + 1024 * rep; float* cst = (float*)(ws + WS_CST); float* nst = (float*)(ws + WS_NST);
            for (;;) {
                __syncthreads();
                if (tid == 0) MISC[0] = __hip_atomic_fetch_add(qhead, 1u, __ATOMIC_RELAXED, __HIP_MEMORY_SCOPE_AGENT);
                __syncthreads();
                const int un = (int)MISC[0];
                if (un >= NUNITS) break;
                if (un < 112) { if (!PHON(16) && !(rep == 1 && PHON(18))) { const int so = un < 48, v_ = so ? un : un - 48;
                    mls::mlstm_unit(lds, (v_ & 15) >> 2, v_ & 3, v_ >> 4, so, qc, kc, z, li, lf, hm, cst, nst, p1cnt, ctl + CW_BAR + XB_TMO); } }
                else if (!PHON(17) && !(rep == 1 && PHON(19))) { const int i = un - 112; att::attn_unit((LAS char*)lds, i & 15, (NQB - 1) - (i >> 4), qf, kvf, krr, cosT, sinT, hcat); }
            }
            if (BOTH(pb + 3)) GRID_BAR();
        } }
        if (PHON(5) && IN(pb + 4)) { for (int rep = 0; rep < NREP(5); ++rep) {
            p_hcat(hm, z, P.in[6] + (size_t)l * 2048, hcat, gw, NGW, lane);
            if (BOTH(pb + 4)) GRID_BAR();
        } }
        if (PHON(6) && IN(pb + 5)) { for (int rep = 0; rep < NREP(6); ++rep) {
            pg8::Gemm g{hcat, w_ptr(ws, l, 3), R, DM, DM, DM, DM}; pg8::StaticOrder S; S.init(R, DM, G, bx);
            pg8::EpiBf16 E{mix, DM}; pg8::gemm_phase<pg8::EpiBf16>(lds, g, S, E);
            if (BOTH(pb + 5)) GRID_BAR();
        } }
        if (PHON(7) && IN(pb + 6)) {
            p_resnorm(mix, hres, P.in[12] + (size_t)l * DM, P.in[13] + (size_t)l * DM, u, nullptr, gw, NGW, lane);
            if (BOTH(pb + 6)) GRID_BAR();
        }
        if (PHON(8) && IN(pb + 7)) { for (int rep = 0; rep < NREP(8); ++rep) {
            pg8::Gemm g{u, w_ptr(ws, l, 4), R, NGU, DM, DM, DM}; pg8::StaticOrder S; S.init(R, NGU, G, bx);
            pg8::EpiSwiGLU E{act, DFF}; pg8::gemm_phase<pg8::EpiSwiGLU>(lds, g, S, E);
            if (BOTH(pb + 7)) GRID_BAR();
        } }
        if (PHON(9) && IN(pb + 8)) { for (int rep = 0; rep < NREP(9); ++rep) {
            pg8::Gemm g{act, w_ptr(ws, l, 5), R, DM, DFF, DFF, DFF}; pg8::StaticOrder S; S.init(R, DM, G, bx);
            pg8::EpiBf16 E{yb, DM}; pg8::gemm_phase<pg8::EpiBf16>(lds, g, S, E);
            if (BOTH(pb + 8)) GRID_BAR();
        } }
        if (PHON(10) && IN(pb + 9)) {
            if (l == 0) p_resnorm(yb, hres, P.in[16], P.in[2] + DM, u, nullptr, gw, NGW, lane);
            else p_resnorm(yb, hres, P.in[16] + DM, nullptr, nullptr, P.out, gw, NGW, lane);
            if (BOTH(pb + 9)) GRID_BAR();
        }
    }
#undef IN
#undef BOTH
}

extern "C" void kernel_launch(void* const* d_in, const int* in_sizes, int n_in, void* d_out, int out_size, void* d_ws, size_t ws_size, hipStream_t stream) {
    static int grid = 0;
    if (grid == 0) {
        if (n_in != 17 || out_size != SEQ * DM || ws_size < WS_END) { fprintf(stderr, "kernel_launch: unexpected shapes (n_in %d, out %d, ws %zu < %zu)\n", n_in, out_size, ws_size, (size_t)WS_END); grid = -1; return; }
        int dev = 0, cus = 0, per_cu = 0;
        if (hipGetDevice(&dev) != hipSuccess || hipDeviceGetAttribute(&cus, hipDeviceAttributeMultiprocessorCount, dev) != hipSuccess) { grid = -1; return; }
        if (hipFuncSetAttribute((const void*)fwd_kernel, hipFuncAttributeMaxDynamicSharedMemorySize, LDS_BYTES) != hipSuccess) { fprintf(stderr, "kernel_launch: hipFuncSetAttribute failed\n"); grid = -1; return; }
        if (hipOccupancyMaxActiveBlocksPerMultiprocessor(&per_cu, (const void*)fwd_kernel, 512, LDS_BYTES) != hipSuccess || per_cu < 1) fprintf(stderr, "kernel_launch: occupancy query reports %d\n", per_cu);
        (void)hipGetLastError();
        grid = cus;
    }
    if (grid < 0) return;
    (void)hipMemsetAsync((char*)d_ws + WS_CTL, 0, CTL_BYTES, stream);
    Args a{};
    for (int i = 0; i < 17; ++i) a.p.in[i] = (const float*)d_in[i];
    a.p.out = (float*)d_out; a.p.ws = (unsigned char*)d_ws;
#if MK_PER_PHASE
    for (int ph = 0; ph < NPHASE; ++ph) { a.ph_lo = ph; a.ph_hi = ph + 1; hipLaunchKernelGGL(fwd_kernel, dim3(grid), dim3(512), LDS_BYTES, stream, a); }
#else
    a.ph_lo = 0; a.ph_hi = NPHASE;
    hipLaunchKernelGGL(fwd_kernel, dim3(grid), dim3(512), LDS_BYTES, stream, a);
#endif
}
```

```cpp
#include <hip/hip_runtime.h>
#include <cstdio>
#include <cstdint>

#ifndef MK_PER_PHASE
#define MK_PER_PHASE 0
#endif

#define LAS __attribute__((address_space(3)))
typedef unsigned short bf16_t;
typedef short bf16x8 __attribute__((ext_vector_type(8)));
typedef short s16x4 __attribute__((ext_vector_type(4)));
typedef float f32x4 __attribute__((ext_vector_type(4)));
typedef float f32x16 __attribute__((ext_vector_type(16)));
typedef unsigned u32x4 __attribute__((ext_vector_type(4)));
typedef unsigned u32x2 __attribute__((ext_vector_type(2)));

constexpr int DM = 4096, SEQ = 16384, NMETA = 16;
constexpr int RFIRST = 240;
constexpr int R = 16640;
constexpr int NIN = 8448;
constexpr int ZQ = 0, ZK = 1024, ZV = 2048, ZO = 4096, ZCQ = 6144, ZCKV = 7680, ZKR = 8192, ZGI = 8256, ZGF = 8260;
constexpr int NIN_SRC = 8264;
constexpr int QL = 1536, KVL = 512, NQF = 3072, NKVF = 4096;
constexpr int DFF = 11008, NGU = 22016;
constexpr float EPS = 1e-6f;
constexpr int NCHUNK = R / 64;
constexpr int NQB = R / 256;

constexpr size_t MiB = 1u << 20;
constexpr size_t WS_CTL = 0, CTL_BYTES = 1 * MiB;
constexpr size_t WS_COS = 2 * MiB, WS_SIN = 5 * MiB;
constexpr size_t WS_LI = 8 * MiB, WS_LF = 9 * MiB;
constexpr size_t SZ_WIN = (size_t)NIN * DM * 2, SZ_WUQ = (size_t)NQF * QL * 2, SZ_WUKV = (size_t)NKVF * KVL * 2,
                 SZ_WOUT = (size_t)DM * DM * 2, SZ_WGU = (size_t)NGU * DM * 2, SZ_WDN = (size_t)DM * DFF * 2;
constexpr size_t SZ_WL = SZ_WIN + SZ_WUQ + SZ_WUKV + SZ_WOUT + SZ_WGU + SZ_WDN;
constexpr size_t WS_W = 16 * MiB;
constexpr size_t WS_HRES = WS_W + 2 * SZ_WL;
constexpr size_t WS_U = WS_HRES + (size_t)R * DM * 4;
constexpr size_t WS_Z = WS_U + (size_t)R * DM * 2;
constexpr size_t WS_QC = WS_Z + (size_t)R * NIN * 2;
constexpr size_t WS_KC = WS_QC + (size_t)R * 1024 * 2;
constexpr size_t WS_CQN = WS_KC + (size_t)R * 1024 * 2;
constexpr size_t WS_CKVN = WS_CQN + (size_t)R * QL * 2;
constexpr size_t WS_KRR = WS_CKVN + (size_t)R * KVL * 2;
constexpr size_t WS_QF = WS_KRR + (size_t)R * 64 * 2;
constexpr size_t WS_KVF = WS_QF + (size_t)R * NQF * 2;
constexpr size_t WS_HM = WS_KVF + (size_t)R * NKVF * 2;
constexpr size_t WS_HCAT = WS_HM + (size_t)R * 2048 * 4;
constexpr size_t WS_CST = WS_HCAT + (size_t)R * DM * 2;
constexpr size_t WS_NST = WS_CST + (size_t)3 * 16 * 512 * 64 * 4;
constexpr size_t WS_END = WS_NST + (size_t)3 * 16 * 256 * 4;
static_assert((size_t)R * DFF * 2 <= WS_CKVN - WS_Z, "act overlay fits in z|qc|kc|cqn");
constexpr int CW_BAR = 4096;
constexpr int CW_Q = 16384;
constexpr int CW_P1 = 32768;

__device__ __forceinline__ float bf2f(unsigned short b) { return __uint_as_float(((unsigned)b) << 16); }
__device__ __forceinline__ float bflo(unsigned w) { return __uint_as_float(w << 16); }
__device__ __forceinline__ float bfhi(unsigned w) { return __uint_as_float(w & 0xffff0000u); }
__device__ __forceinline__ unsigned cvt_pk_bf16(float lo, float hi) { unsigned r; asm volatile("v_cvt_pk_bf16_f32 %0, %1, %2" : "=v"(r) : "v"(lo), "v"(hi)); return r; }
__device__ __forceinline__ unsigned short f2bf(float f) { return (unsigned short)(cvt_pk_bf16(f, 0.f) & 0xffffu); }
__device__ __forceinline__ float wave_sum(float v) {
#pragma unroll
    for (int o = 1; o < 64; o <<= 1) v += __shfl_xor(v, o);
    return v;
}
__device__ __forceinline__ float fexp(float x) { return __builtin_amdgcn_exp2f(x * 1.4426950408889634f); }
__device__ __forceinline__ int opaque(int x) { asm volatile("" : "+v"(x)); return x; }
#define LDS_WAIT() asm volatile("s_waitcnt lgkmcnt(0)" ::: "memory")
#define SBAR() __builtin_amdgcn_sched_barrier(0)

#define XB_TMO      128
#define XB_XCNT(j)  (256  + 64 * (j))
#define XB_XSUB(j)  (1280 + 64 * (j))
#define XB_XGEN(j)  (2304 + 64 * (j))
#define XB_TOP      3328
#define XB_TOPGEN   3392
#define XCD_BAR_WORDS 3456
#define XB_SPIN_CAP (1u << 20)

__device__ __forceinline__ unsigned xb_ld(unsigned* p)              { return __hip_atomic_load(p, __ATOMIC_RELAXED, __HIP_MEMORY_SCOPE_AGENT); }
__device__ __forceinline__ unsigned xb_add(unsigned* p, unsigned v) { return __hip_atomic_fetch_add(p, v, __ATOMIC_RELAXED, __HIP_MEMORY_SCOPE_AGENT); }
__device__ __forceinline__ unsigned xb_xcc_id() { return (unsigned)__builtin_amdgcn_s_getreg((3 << 11) | 20) & 0xFu; }
#define XB_SPIN(cond, bar) do { unsigned _sp = 0; while (cond) { __builtin_amdgcn_s_sleep(1); \
    if ((++_sp & 255u) == 0u) { if (xb_ld(&(bar)[XB_TMO])) break; if (_sp > XB_SPIN_CAP) { atomicAdd(&(bar)[XB_TMO], 1u); break; } } } } while (0)

struct XcdBarrier { unsigned* bar; unsigned x; volatile LAS unsigned* st; };

__device__ __forceinline__ XcdBarrier xcd_barrier_post(unsigned* bar, volatile LAS unsigned* st) {
    XcdBarrier b; b.bar = bar; b.x = xb_xcc_id(); b.st = st;
    if (threadIdx.x == 0) (void)xb_add(&bar[XB_XCNT(b.x)], 1u);
    return b;
}
__device__ __forceinline__ void xcd_barrier_complete(unsigned* bar, unsigned x, unsigned& nloc, unsigned& nx) {
    const unsigned G = gridDim.x * gridDim.y * gridDim.z;
    unsigned sum, cnt, mine, sp = 0u;
    for (;;) {
        sum = 0u; cnt = 0u; mine = 0u;
#pragma unroll
        for (unsigned j = 0; j < 16; ++j) { const unsigned c = xb_ld(&bar[XB_XCNT(j)]); sum += c; cnt += (c > 0u) ? 1u : 0u; mine = (j == x) ? c : mine; }
        if (sum == G) break;
        __builtin_amdgcn_s_sleep(1);
        if ((++sp & 255u) == 0u) { if (xb_ld(&bar[XB_TMO])) break; if (sp > XB_SPIN_CAP) { atomicAdd(&bar[XB_TMO], 1u); break; } }
    }
    nloc = mine > 0u ? mine : 1u; nx = cnt > 0u ? cnt : 1u;
}
__device__ __forceinline__ void xcd_barrier(const XcdBarrier& b) {
    asm volatile("s_waitcnt vmcnt(0)" ::: "memory");
    __syncthreads();
    if (threadIdx.x == 0) {
        unsigned* bar = b.bar;
        __builtin_amdgcn_s_waitcnt(0);
        unsigned nloc = b.st[0], nx = b.st[1];
        if (nloc == 0u) { xcd_barrier_complete(bar, b.x, nloc, nx); b.st[0] = nloc; b.st[1] = nx; }
        const unsigned old = xb_add(&bar[XB_XSUB(b.x)], 1u);
        const unsigned gen = old / nloc;
        if (old + 1u == (gen + 1u) * nloc) {
            __builtin_amdgcn_fence(__ATOMIC_RELEASE, "agent");
            asm volatile("s_waitcnt vmcnt(0)" ::: "memory");
            const unsigned og = xb_add(&bar[XB_TOP], 1u);
            const unsigned tg = og / nx;
            if (og + 1u == (tg + 1u) * nx) xb_add(&bar[XB_TOPGEN], 1u);
            else XB_SPIN(xb_ld(&bar[XB_TOPGEN]) == tg, bar);
            __builtin_amdgcn_fence(__ATOMIC_ACQUIRE, "agent");
            xb_add(&bar[XB_XGEN(b.x)], 1u);
            asm volatile("s_waitcnt vmcnt(0)" ::: "memory");
        } else {
            XB_SPIN(xb_ld(&bar[XB_XGEN(b.x)]) == gen, bar);
            __builtin_amdgcn_fence(__ATOMIC_ACQUIRE, "agent");
            asm volatile("s_waitcnt vmcnt(0)" ::: "memory");
        }
    }
    __syncthreads();
}

namespace pg8 {
constexpr int BM = 256, BK = 64, HALF = 128, HTB = HALF * BK * 2, STAGE_BYTES = 8 * HTB, NXCD = 8, WGM = 8;
__device__ __forceinline__ int lds_byte(int r, int c) { const int st = (r >> 4) * 2 + (c >> 5), rr = r & 15, cc = c & 31, ob = rr * 64 + cc * 2; return st * 1024 + (ob ^ (((ob >> 9) & 1) << 5)); }
__device__ __forceinline__ void stage_rc(int b, int& R_, int& C) { const int st = b / 1024, sb = b % 1024, swz = sb ^ (((sb >> 9) & 1) << 5); R_ = (st >> 1) * 16 + swz / 64; C = (st & 1) * 32 + (swz % 64) / 2; }
__device__ __forceinline__ int perm32(int rho) { const int n = rho >> 4, i = rho & 15; return 8 * (i >> 2) + 4 * n + (i & 3); }
struct Unit { int pm, pn; };
struct Gemm { const bf16_t* A; const bf16_t* Bt; int M, N, K, lda, ldb; };
struct StaticOrder {
    int nM, nN, nwg, G, c;
    __device__ void init(int M, int N, int G_, int c_) { nM = M / BM; nN = N / BM; nwg = nM * nN; G = G_; c = c_; }
    __device__ bool next(int i, Unit& u) const {
        const long L = (long)i * G + c; if (L >= nwg) return false;
        int wgid = (int)L; { const int q = nwg / NXCD, r = nwg % NXCD, xcd = wgid % NXCD, off = wgid / NXCD; wgid = (xcd < r ? xcd * (q + 1) : r * (q + 1) + (xcd - r) * q) + off; }
        const int nig = WGM * nN, gid = wgid / nig, fm = gid * WGM, gsz = (nM - fm) < WGM ? (nM - fm) : WGM;
        u.pm = fm + ((wgid % nig) % gsz); u.pn = (wgid % nig) / gsz; return true;
    }
};
struct EpiBf16 {
    static constexpr bool PERM = true;
    bf16_t* O; int ldc;
    __device__ __forceinline__ void operator()(const f32x4 (&acc)[2][2][4][2], const Unit& u, int wr, int wc, int fr, int fq) const {
        const int row0 = u.pm * BM + wr * 64 + fr, col0 = u.pn * BM + wc * 32 + 8 * fq;
#pragma unroll
        for (int ai = 0; ai < 2; ++ai)
#pragma unroll
            for (int m = 0; m < 4; ++m) { bf16_t* rowp = O + (size_t)(row0 + ai * HALF + m * 16) * ldc + col0;
#pragma unroll
                for (int bj = 0; bj < 2; ++bj) { const f32x4 v0 = acc[ai][bj][m][0], v1 = acc[ai][bj][m][1];
                    u32x4 w; w.x = cvt_pk_bf16(v0[0], v0[1]); w.y = cvt_pk_bf16(v0[2], v0[3]); w.z = cvt_pk_bf16(v1[0], v1[1]); w.w = cvt_pk_bf16(v1[2], v1[3]);
                    *(u32x4*)(rowp + bj * HALF) = w; } }
    }
};
__device__ __forceinline__ float silu_mul(float g, float u) { return g * u * __builtin_amdgcn_rcpf(1.0f + __builtin_amdgcn_exp2f(-g * 1.4426950408889634f)); }
struct EpiSwiGLU {
    static constexpr bool PERM = true;
    bf16_t* O; int ldc;
    __device__ __forceinline__ void operator()(const f32x4 (&acc)[2][2][4][2], const Unit& u, int wr, int wc, int fr, int fq) const {
        const int row0 = u.pm * BM + wr * 64 + fr, col0 = u.pn * HALF + wc * 32 + 8 * fq;
#pragma unroll
        for (int ai = 0; ai < 2; ++ai)
#pragma unroll
            for (int m = 0; m < 4; ++m) { bf16_t* rowp = O + (size_t)(row0 + ai * HALF + m * 16) * ldc + col0;
                const f32x4 g0 = acc[ai][0][m][0], g1 = acc[ai][0][m][1], u0 = acc[ai][1][m][0], u1 = acc[ai][1][m][1];
                u32x4 w; w.x = cvt_pk_bf16(silu_mul(g0[0], u0[0]), silu_mul(g0[1], u0[1])); w.y = cvt_pk_bf16(silu_mul(g0[2], u0[2]), silu_mul(g0[3], u0[3]));
                w.z = cvt_pk_bf16(silu_mul(g1[0], u1[0]), silu_mul(g1[1], u1[1])); w.w = cvt_pk_bf16(silu_mul(g1[2], u1[2]), silu_mul(g1[3], u1[3]));
                *(u32x4*)rowp = w; }
    }
};

template <class Epi>
__device__ __forceinline__ void gemm_phase(LAS unsigned char* lds, const Gemm g, const StaticOrder& S, const Epi& E) {
    const int tid = opaque(threadIdx.x), wid = __builtin_amdgcn_readfirstlane(tid >> 6), lane = tid & 63, wr = wid >> 2, wc = wid & 3, fr = lane & 15, fq = lane >> 4;
    const int K = g.K, nt = K / BK;
    unsigned voffA[2], voffB[2];
#pragma unroll
    for (int i = 0; i < 2; ++i) { int R_, C; stage_rc(tid * 16 + i * 8192, R_, C); const int Rb = Epi::PERM ? ((R_ & ~31) + perm32(R_ & 31)) : R_;
        voffA[i] = (unsigned)(R_ * g.lda + C) * 2u; voffB[i] = (unsigned)(Rb * g.ldb + C) * 2u; }
    const size_t kstep = (size_t)(BK * 2);
    const size_t hstepA = (size_t)HALF * g.lda * 2, hstepB = (size_t)HALF * g.ldb * 2;
    const size_t tstepA = 2 * hstepA, tstepB = 2 * hstepB;
    const unsigned ldsw = (unsigned)wid * 1024u;
    const int aoff = lds_byte(wr * 64 + fr, fq * 8), boff = lds_byte(wc * 32 + fr, fq * 8);
#define PG8_SA(b, h) (((b) * 2 + (h)) * HTB)
#define PG8_SB(b, h) ((4 + (b) * 2 + (h)) * HTB)
#define PG8_STAGE(bufoff, gbase, voff) do { _Pragma("unroll") for (int _i = 0; _i < 2; ++_i) \
        __builtin_amdgcn_global_load_lds((const unsigned*)((const char*)(gbase) + (voff)[_i]), (LAS unsigned*)(lds + (bufoff) + ldsw + _i * 8192), 16, 0, 0); } while (0)
#define PG8_LDA(dst, b, h) do { _Pragma("unroll") for (int m = 0; m < 4; ++m) _Pragma("unroll") for (int k = 0; k < 2; ++k) dst[m][k] = *(const LAS bf16x8*)(lds + PG8_SA(b, h) + aoff + m * 2048 + k * 1024); } while (0)
#define PG8_LDB(dst, b, h) do { _Pragma("unroll") for (int n = 0; n < 2; ++n) _Pragma("unroll") for (int k = 0; k < 2; ++k) dst[n][k] = *(const LAS bf16x8*)(lds + PG8_SB(b, h) + boff + n * 2048 + k * 1024); } while (0)
#define PG8_MMA(ai, bj, At, Bt) do { __builtin_amdgcn_s_setprio(1); _Pragma("unroll") for (int m = 0; m < 4; ++m) _Pragma("unroll") for (int n = 0; n < 2; ++n) _Pragma("unroll") for (int k = 0; k < 2; ++k) \
        acc[ai][bj][m][n] = __builtin_amdgcn_mfma_f32_16x16x32_bf16(Bt[n][k], At[m][k], acc[ai][bj][m][n], 0, 0, 0); __builtin_amdgcn_s_setprio(0); } while (0)
#define PG8_WAIT_V(n) asm volatile("s_waitcnt vmcnt(" #n ")" ::: "memory")
#define PG8_WAIT_L(n) asm volatile("s_waitcnt lgkmcnt(" #n ")" ::: "memory")
#define PG8_BAR __builtin_amdgcn_s_barrier()
#define PG8_SCHED __builtin_amdgcn_sched_barrier(0)
    Unit cur, nxt; int ui = 0;
    if (!S.next(0, cur)) return;
    f32x4 acc[2][2][4][2];
#pragma unroll
    for (int a = 0; a < 2; ++a)
#pragma unroll
        for (int b = 0; b < 2; ++b)
#pragma unroll
            for (int m = 0; m < 4; ++m)
#pragma unroll
                for (int n = 0; n < 2; ++n) acc[a][b][m][n] = (f32x4){0.f, 0.f, 0.f, 0.f};
    bf16x8 At[4][2], B0[2][2], B1[2][2];
    const char* cA = (const char*)g.A + (size_t)cur.pm * tstepA; const char* cB = (const char*)g.Bt + (size_t)cur.pn * tstepB;
    PG8_STAGE(PG8_SB(0, 0), cB, voffB); PG8_STAGE(PG8_SA(0, 0), cA, voffA); PG8_STAGE(PG8_SB(0, 1), cB + hstepB, voffB); PG8_STAGE(PG8_SA(0, 1), cA + hstepA, voffA);
    if (wr == 1) PG8_BAR;
    PG8_WAIT_V(4); PG8_BAR;
    PG8_STAGE(PG8_SB(1, 0), cB + kstep, voffB); PG8_STAGE(PG8_SA(1, 0), cA + kstep, voffA); PG8_STAGE(PG8_SB(1, 1), cB + hstepB + kstep, voffB);
    PG8_WAIT_V(6); PG8_BAR;
    for (;;) {
        const bool has_next = S.next(ui + 1, nxt);
        const char* nA = has_next ? (const char*)g.A + (size_t)nxt.pm * tstepA : cA; const char* nB = has_next ? (const char*)g.Bt + (size_t)nxt.pn * tstepB : cB;
        for (int t = 0; t < nt; t += 2) {
            const bool last = (t == nt - 2);
            const char* a1 = cA + (size_t)(t + 1) * kstep;
            const char* a2 = last ? nA : cA + (size_t)(t + 2) * kstep; const char* b2 = last ? nB : cB + (size_t)(t + 2) * kstep;
            const char* a3 = a2 + kstep; const char* b3 = b2 + kstep;
            PG8_LDB(B0, 0, 0); PG8_SCHED; PG8_LDA(At, 0, 0); PG8_STAGE(PG8_SA(1, 1), a1 + hstepA, voffA);
            PG8_WAIT_L(8); PG8_BAR; PG8_WAIT_L(0); PG8_MMA(0, 0, At, B0); PG8_BAR; PG8_SCHED;
            PG8_LDB(B1, 0, 1); PG8_STAGE(PG8_SB(0, 0), b2, voffB);
            PG8_BAR; PG8_WAIT_L(0); PG8_MMA(0, 1, At, B1); PG8_BAR;
            PG8_LDA(At, 0, 1); PG8_STAGE(PG8_SA(0, 0), a2, voffA);
            PG8_BAR; PG8_WAIT_L(0); PG8_MMA(1, 0, At, B0); PG8_BAR; PG8_SCHED;
            PG8_STAGE(PG8_SB(0, 1), b2 + hstepB, voffB);
            PG8_WAIT_V(6); PG8_BAR; PG8_MMA(1, 1, At, B1); PG8_BAR;
            PG8_LDB(B0, 1, 0); PG8_SCHED; PG8_LDA(At, 1, 0); PG8_STAGE(PG8_SA(0, 1), a2 + hstepA, voffA);
            PG8_WAIT_L(8); PG8_BAR; PG8_WAIT_L(0); PG8_MMA(0, 0, At, B0); PG8_BAR; PG8_SCHED;
            PG8_LDB(B1, 1, 1); PG8_STAGE(PG8_SB(1, 0), b3, voffB);
            PG8_BAR; PG8_WAIT_L(0); PG8_MMA(0, 1, At, B1); PG8_BAR;
            PG8_LDA(At, 1, 1); PG8_STAGE(PG8_SA(1, 0), a3, voffA);
            PG8_BAR; PG8_WAIT_L(0); PG8_MMA(1, 0, At, B0); PG8_BAR; PG8_SCHED;
            PG8_STAGE(PG8_SB(1, 1), b3 + hstepB, voffB);
            PG8_WAIT_V(6); PG8_BAR; PG8_MMA(1, 1, At, B1); PG8_BAR;
        }
        E(acc, cur, wr, wc, fr, fq);
        if (!has_next) break;
#pragma unroll
        for (int a = 0; a < 2; ++a)
#pragma unroll
            for (int b = 0; b < 2; ++b)
#pragma unroll
                for (int m = 0; m < 4; ++m)
#pragma unroll
                    for (int n = 0; n < 2; ++n) acc[a][b][m][n] = (f32x4){0.f, 0.f, 0.f, 0.f};
        cur = nxt; cA = nA; cB = nB; ++ui;
    }
    PG8_WAIT_V(0);
    if (wr == 0) PG8_BAR;
    PG8_BAR;
#undef PG8_SA
#undef PG8_SB
#undef PG8_STAGE
#undef PG8_LDA
#undef PG8_LDB
#undef PG8_MMA
#undef PG8_WAIT_V
#undef PG8_WAIT_L
#undef PG8_BAR
#undef PG8_SCHED
}
}


__device__ __forceinline__ void thin_gemm16(LAS unsigned char* lds, const bf16_t* A, int lda, const bf16_t* Bt, int ldb, int K, int N, bf16_t* O, int ldc, int bx, int G) {
    const int tid = opaque(threadIdx.x), wave = __builtin_amdgcn_readfirstlane(tid >> 6), lane = tid & 63, n16 = lane & 15, g = lane >> 4;
    LAS f32x4* red = (LAS f32x4*)lds;
    const int nsteps = K / 32;
    for (int nt = bx; nt < N / 16; nt += G) {
        const bf16_t* ap = A + (size_t)n16 * lda + 8 * g; const bf16_t* bp = Bt + (size_t)(nt * 16 + n16) * ldb + 8 * g;
        f32x4 acc = (f32x4){0.f, 0.f, 0.f, 0.f};
        int ks = wave;
        for (; ks + 24 < nsteps; ks += 32) {
            bf16x8 a0 = *(const bf16x8*)(ap + (size_t)ks * 32), b0 = *(const bf16x8*)(bp + (size_t)ks * 32);
            bf16x8 a1 = *(const bf16x8*)(ap + (size_t)(ks + 8) * 32), b1 = *(const bf16x8*)(bp + (size_t)(ks + 8) * 32);
            bf16x8 a2 = *(const bf16x8*)(ap + (size_t)(ks + 16) * 32), b2 = *(const bf16x8*)(bp + (size_t)(ks + 16) * 32);
            bf16x8 a3 = *(const bf16x8*)(ap + (size_t)(ks + 24) * 32), b3 = *(const bf16x8*)(bp + (size_t)(ks + 24) * 32);
            acc = __builtin_amdgcn_mfma_f32_16x16x32_bf16(a0, b0, acc, 0, 0, 0); acc = __builtin_amdgcn_mfma_f32_16x16x32_bf16(a1, b1, acc, 0, 0, 0);
            acc = __builtin_amdgcn_mfma_f32_16x16x32_bf16(a2, b2, acc, 0, 0, 0); acc = __builtin_amdgcn_mfma_f32_16x16x32_bf16(a3, b3, acc, 0, 0, 0);
        }
        for (; ks < nsteps; ks += 8) { const bf16x8 a0 = *(const bf16x8*)(ap + (size_t)ks * 32), b0 = *(const bf16x8*)(bp + (size_t)ks * 32);
            acc = __builtin_amdgcn_mfma_f32_16x16x32_bf16(a0, b0, acc, 0, 0, 0); }
        red[wave * 64 + lane] = acc;
        __syncthreads();
        if (wave == 0) { f32x4 t = red[lane];
#pragma unroll
            for (int w = 1; w < 8; ++w) t += red[w * 64 + lane];
#pragma unroll
            for (int i = 0; i < 4; ++i) O[(size_t)(4 * g + i) * ldc + nt * 16 + n16] = f2bf(t[i]); }
        __syncthreads();
    }
}

template <int MAP> __device__ __forceinline__ int map_col(int n) {
    if (MAP == 0) return n;
    if (MAP == 1) return n < 6144 ? n : (n < 8256 ? n + 8 : (n < 8264 ? n - 2112 : -1));
    const int T = n >> 8, w = n & 255; return w < 128 ? 128 * T + w : DFF + 128 * T + (w - 128);
}
template <int MAP> __device__ __forceinline__ void cvt_matrix(const float* W, int K, int Nsrc, bf16_t* WT, int Ndst, LAS float* scr, int lane, int gw, int NGW) {
    const int nblk = Ndst / 32, nitems = (K / 64) * nblk;
    for (int item = gw; item < nitems; item += NGW) {
        const int kb = item / nblk, nb = item % nblk, k0 = 64 * kb, n0 = 32 * nb;
        const int src = map_col<MAP>(n0 + (lane & 31));
        const float* wp = W + (size_t)(k0 + (lane >> 5)) * Nsrc + (src >= 0 ? src : 0);
#pragma unroll 8
        for (int i = 0; i < 32; ++i) { const int kk = 2 * i + (lane >> 5); float v = wp[(size_t)(2 * i) * Nsrc]; if (src < 0) v = 0.f; scr[kk * 33 + (lane & 31)] = v; }
        LDS_WAIT();
        const int c = lane & 7;
#pragma unroll
        for (int j = 0; j < 4; ++j) { const int n = (lane >> 3) + 8 * j; const LAS float* s = scr + (8 * c) * 33 + n;
            u32x4 o; o.x = cvt_pk_bf16(s[0 * 33], s[1 * 33]); o.y = cvt_pk_bf16(s[2 * 33], s[3 * 33]); o.z = cvt_pk_bf16(s[4 * 33], s[5 * 33]); o.w = cvt_pk_bf16(s[6 * 33], s[7 * 33]);
            *(u32x4*)(WT + (size_t)(n0 + n) * K + k0 + 8 * c) = o; }
        LDS_WAIT();
    }
}

struct Ptrs {
    const float* in[17]; float* out; unsigned char* ws;
};
__device__ __forceinline__ bf16_t* w_ptr(unsigned char* ws, int l, int which) {
    size_t off = WS_W + (size_t)l * SZ_WL;
    if (which > 0) off += SZ_WIN; if (which > 1) off += SZ_WUQ; if (which > 2) off += SZ_WUKV; if (which > 3) off += SZ_WOUT; if (which > 4) off += SZ_WGU;
    return (bf16_t*)(ws + off);
}

__device__ __forceinline__ void p_prologue(const Ptrs& P, LAS unsigned char* lds, int gw, int NGW, int wave, int lane) {
    lane = opaque(lane); gw = opaque(gw);
    LAS float* scr = (LAS float*)(lds + wave * 8704);
    for (int l = 0; l < 2; ++l) {
        cvt_matrix<1>(P.in[3] + (size_t)l * DM * NIN_SRC, DM, NIN_SRC, w_ptr(P.ws, l, 0), NIN, scr, lane, gw, NGW);
        cvt_matrix<0>(P.in[8] + (size_t)l * QL * NQF, QL, NQF, w_ptr(P.ws, l, 1), NQF, scr, lane, gw, NGW);
        cvt_matrix<0>(P.in[10] + (size_t)l * KVL * NKVF, KVL, NKVF, w_ptr(P.ws, l, 2), NKVF, scr, lane, gw, NGW);
        cvt_matrix<0>(P.in[11] + (size_t)l * DM * DM, DM, DM, w_ptr(P.ws, l, 3), DM, scr, lane, gw, NGW);
        cvt_matrix<2>(P.in[14] + (size_t)l * DM * NGU, DM, NGU, w_ptr(P.ws, l, 4), NGU, scr, lane, gw, NGW);
        cvt_matrix<0>(P.in[15] + (size_t)l * DFF * DM, DFF, DM, w_ptr(P.ws, l, 5), DM, scr, lane, gw, NGW);
    }
    float* cosT = (float*)(P.ws + WS_COS); float* sinT = (float*)(P.ws + WS_SIN);
    for (int idx = gw * 64 + lane; idx < R * 32; idx += NGW * 64) {
        const int r = idx >> 5, i = idx & 31; const int pos = r >= RFIRST ? r - RFIRST : 0;
        const float invf = (float)pow(10000.0, -(double)i / 32.0);
        const float ang = (float)pos * invf;
        cosT[idx] = (float)cos((double)ang); sinT[idx] = (float)sin((double)ang);
    }
    float* hres = (float*)(P.ws + WS_HRES); bf16_t* u = (bf16_t*)(P.ws + WS_U);
    const float* g0 = P.in[2];
    for (int r = gw; r < R; r += NGW) {
        f32x4* hr = (f32x4*)(hres + (size_t)r * DM); u32x2* ur = (u32x2*)(u + (size_t)r * DM);
        if (r < RFIRST) {
#pragma unroll
            for (int j = 0; j < 16; ++j) { hr[64 * j + lane] = (f32x4){0.f, 0.f, 0.f, 0.f}; ur[64 * j + lane] = (u32x2){0u, 0u}; }
            continue;
        }
        const f32x4* src = (const f32x4*)(r < 256 ? P.in[1] + (size_t)(r - RFIRST) * DM : P.in[0] + (size_t)(r - 256) * DM);
        f32x4 v[16]; float ss = 0.f;
#pragma unroll
        for (int j = 0; j < 16; ++j) { v[j] = src[64 * j + lane]; ss += (v[j][0] * v[j][0] + v[j][1] * v[j][1]) + (v[j][2] * v[j][2] + v[j][3] * v[j][3]); }
        const float rs = 1.0f / sqrtf(wave_sum(ss) * (1.0f / DM) + EPS);
#pragma unroll
        for (int j = 0; j < 16; ++j) { hr[64 * j + lane] = v[j]; const f32x4 g = ((const f32x4*)g0)[64 * j + lane];
            ur[64 * j + lane] = (u32x2){cvt_pk_bf16(v[j][0] * rs * g[0], v[j][1] * rs * g[1]), cvt_pk_bf16(v[j][2] * rs * g[2], v[j][3] * rs * g[3])}; }
    }
}

__device__ __forceinline__ void p_resnorm(const bf16_t* y, float* hres, const float* gpost, const float* gnext, bf16_t* u, float* out, int gw, int NGW, int lane) {
    lane = opaque(lane); gw = opaque(gw);
    for (int r = gw; r < R; r += NGW) {
        if (r < RFIRST) continue;
        f32x4* hr = (f32x4*)(hres + (size_t)r * DM); const u32x2* yr = (const u32x2*)(y + (size_t)r * DM);
        f32x4 v[16]; float ss = 0.f;
#pragma unroll
        for (int j = 0; j < 16; ++j) { const u32x2 w = yr[64 * j + lane]; v[j] = (f32x4){bflo(w.x), bfhi(w.x), bflo(w.y), bfhi(w.y)};
            ss += (v[j][0] * v[j][0] + v[j][1] * v[j][1]) + (v[j][2] * v[j][2] + v[j][3] * v[j][3]); }
        const float rs = 1.0f / sqrtf(wave_sum(ss) * (1.0f / DM) + EPS);
        float ss2 = 0.f;
#pragma unroll
        for (int j = 0; j < 16; ++j) { const f32x4 g = ((const f32x4*)gpost)[64 * j + lane]; const f32x4 x = hr[64 * j + lane];
            v[j] = x + v[j] * rs * g; ss2 += (v[j][0] * v[j][0] + v[j][1] * v[j][1]) + (v[j][2] * v[j][2] + v[j][3] * v[j][3]); }
        if (out) {
            if (r >= 256) { f32x4* orow = (f32x4*)(out + (size_t)(r - 256) * DM);
#pragma unroll
                for (int j = 0; j < 16; ++j) orow[64 * j + lane] = v[j]; }
        } else {
            const float rs2 = 1.0f / sqrtf(wave_sum(ss2) * (1.0f / DM) + EPS);
            u32x2* ur = (u32x2*)(u + (size_t)r * DM);
#pragma unroll
            for (int j = 0; j < 16; ++j) { hr[64 * j + lane] = v[j]; const f32x4 g = ((const f32x4*)gnext)[64 * j + lane];
                ur[64 * j + lane] = (u32x2){cvt_pk_bf16(v[j][0] * rs2 * g[0], v[j][1] * rs2 * g[1]), cvt_pk_bf16(v[j][2] * rs2 * g[2], v[j][3] * rs2 * g[3])}; }
        }
    }
}

__device__ __forceinline__ void unpack8(const u32x4 w, float (&f)[8]) {
    f[0] = bflo(w.x); f[1] = bfhi(w.x); f[2] = bflo(w.y); f[3] = bfhi(w.y); f[4] = bflo(w.z); f[5] = bfhi(w.z); f[6] = bflo(w.w); f[7] = bfhi(w.w);
}
__device__ __forceinline__ u32x4 pack8f(const float (&f)[8]) { return (u32x4){cvt_pk_bf16(f[0], f[1]), cvt_pk_bf16(f[2], f[3]), cvt_pk_bf16(f[4], f[5]), cvt_pk_bf16(f[6], f[7])}; }

__device__ __forceinline__ void p_prep(const bf16_t* z, const float* convw, const float* bg, const float* gcq, const float* gckv, const float* cosT, const float* sinT,
                                       bf16_t* qc, bf16_t* kc, float* li, float* lf, bf16_t* cqn, bf16_t* ckvn, bf16_t* krr, int gw, int NGW, int lane) {
    lane = opaque(lane); gw = opaque(gw);
    for (int r = gw; r < R; r += NGW) {
        const bf16_t* zr = z + (size_t)r * NIN;
        if (r < RFIRST) {
            const unsigned zz = (unsigned)opaque(0); const u32x4 zero4 = (u32x4){zz, zz, zz, zz};
#pragma unroll
            for (int j = 0; j < 2; ++j) { *(u32x4*)(qc + (size_t)r * 1024 + 8 * (64 * j + lane)) = zero4; *(u32x4*)(kc + (size_t)r * 1024 + 8 * (64 * j + lane)) = zero4; }
#pragma unroll
            for (int j = 0; j < 3; ++j) *(u32x4*)(cqn + (size_t)r * QL + 8 * (64 * j + lane)) = zero4;
            *(u32x4*)(ckvn + (size_t)r * KVL + 8 * lane) = zero4;
            if (lane < 8) *(u32x4*)(krr + (size_t)r * 64 + 8 * lane) = zero4;
            if (lane < 4) { li[(size_t)r * 4 + lane] = -__builtin_inff(); lf[(size_t)r * 4 + lane] = 0.f; }
            continue;
        }
#pragma unroll
        for (int j = 0; j < 4; ++j) {
            const int c0 = 8 * (64 * j + lane);
            float a[8];
#pragma unroll
            for (int e = 0; e < 8; ++e) a[e] = 0.f;
#pragma unroll
            for (int tap = 0; tap < 4; ++tap) {
                const u32x4 xw = *(const u32x4*)(zr + (ptrdiff_t)(tap - 3) * NIN + c0); float x[8]; unpack8(xw, x);
                const f32x4 w0 = *(const f32x4*)(convw + tap * 2048 + c0), w1 = *(const f32x4*)(convw + tap * 2048 + c0 + 4);
                a[0] += w0[0] * x[0]; a[1] += w0[1] * x[1]; a[2] += w0[2] * x[2]; a[3] += w0[3] * x[3];
                a[4] += w1[0] * x[4]; a[5] += w1[1] * x[5]; a[6] += w1[2] * x[6]; a[7] += w1[3] * x[7];
            }
            const float sc = (c0 < 1024) ? 0.0625f : 1.0f;
#pragma unroll
            for (int e = 0; e < 8; ++e) a[e] = a[e] / (1.0f + __expf(-a[e])) * sc;
            bf16_t* dst = (c0 < 1024) ? qc + (size_t)r * 1024 + c0 : kc + (size_t)r * 1024 + (c0 - 1024);
            *(u32x4*)dst = pack8f(a);
        }
        if (lane < 8) { const float val = bf2f(zr[ZGI + lane]) + bg[lane];
            if (lane < 4) li[(size_t)r * 4 + lane] = val;
            else lf[(size_t)r * 4 + (lane - 4)] = fminf(val, 0.f) - log1pf(__expf(-fabsf(val))); }
        { float x[3][8]; float ss = 0.f;
#pragma unroll
          for (int j = 0; j < 3; ++j) { unpack8(*(const u32x4*)(zr + ZCQ + 8 * (64 * j + lane)), x[j]);
#pragma unroll
              for (int e = 0; e < 8; ++e) ss += x[j][e] * x[j][e]; }
          const float rs = 1.0f / sqrtf(wave_sum(ss) * (1.0f / QL) + EPS);
#pragma unroll
          for (int j = 0; j < 3; ++j) { const int c0 = 8 * (64 * j + lane); const f32x4 g0 = *(const f32x4*)(gcq + c0), g1 = *(const f32x4*)(gcq + c0 + 4);
              float o[8] = {x[j][0] * rs * g0[0], x[j][1] * rs * g0[1], x[j][2] * rs * g0[2], x[j][3] * rs * g0[3], x[j][4] * rs * g1[0], x[j][5] * rs * g1[1], x[j][6] * rs * g1[2], x[j][7] * rs * g1[3]};
              *(u32x4*)(cqn + (size_t)r * QL + c0) = pack8f(o); } }
        { float x[8]; unpack8(*(const u32x4*)(zr + ZCKV + 8 * lane), x); float ss = 0.f;
#pragma unroll
          for (int e = 0; e < 8; ++e) ss += x[e] * x[e];
          const float rs = 1.0f / sqrtf(wave_sum(ss) * (1.0f / KVL) + EPS);
          const f32x4 g0 = *(const f32x4*)(gckv + 8 * lane), g1 = *(const f32x4*)(gckv + 8 * lane + 4);
          float o[8] = {x[0] * rs * g0[0], x[1] * rs * g0[1], x[2] * rs * g0[2], x[3] * rs * g0[3], x[4] * rs * g1[0], x[5] * rs * g1[1], x[6] * rs * g1[2], x[7] * rs * g1[3]};
          *(u32x4*)(ckvn + (size_t)r * KVL + 8 * lane) = pack8f(o); }
        if (lane < 32) { const float x1 = bf2f(zr[ZKR + lane]), x2 = bf2f(zr[ZKR + 32 + lane]); const float c = cosT[(size_t)r * 32 + lane], s = sinT[(size_t)r * 32 + lane];
            krr[(size_t)r * 64 + lane] = f2bf(x1 * c - x2 * s); krr[(size_t)r * 64 + 32 + lane] = f2bf(x1 * s + x2 * c); }
    }
}

__device__ __forceinline__ void p_hcat(const float* hm, const bf16_t* z, const float* gmn, bf16_t* hcat, int gw, int NGW, int lane) {
    lane = opaque(lane); gw = opaque(gw);
    for (int r = gw; r < R; r += NGW) {
        if (r < RFIRST) {
            const unsigned zz = (unsigned)opaque(0); const u32x4 zero4 = (u32x4){zz, zz, zz, zz};
#pragma unroll
            for (int j = 0; j < 8; ++j) *(u32x4*)(hcat + (size_t)r * DM + 8 * (64 * j + lane)) = zero4;
            continue;
        }
#pragma unroll
        for (int h = 0; h < 4; ++h) {
            const int c0 = h * 512 + 8 * lane;
            const f32x4 a = *(const f32x4*)(hm + (size_t)r * 2048 + c0), b = *(const f32x4*)(hm + (size_t)r * 2048 + c0 + 4);
            const float ss = (a[0] * a[0] + a[1] * a[1]) + (a[2] * a[2] + a[3] * a[3]) + (b[0] * b[0] + b[1] * b[1]) + (b[2] * b[2] + b[3] * b[3]);
            const float rs = 1.0f / sqrtf(wave_sum(ss) * (1.0f / 512.0f) + EPS);
            float o[8]; unpack8(*(const u32x4*)(z + (size_t)r * NIN + ZO + c0), o);
            const f32x4 g0 = *(const f32x4*)(gmn + c0), g1 = *(const f32x4*)(gmn + c0 + 4);
            const float hv[8] = {a[0], a[1], a[2], a[3], b[0], b[1], b[2], b[3]}; const float gv[8] = {g0[0], g0[1], g0[2], g0[3], g1[0], g1[1], g1[2], g1[3]};
            float res[8];
#pragma unroll
            for (int e = 0; e < 8; ++e) res[e] = hv[e] * rs * gv[e] / (1.0f + __expf(-o[e]));
            *(u32x4*)(hcat + (size_t)r * DM + c0) = pack8f(res);
        }
    }
}

namespace att {
constexpr float SCALE = 0.07216878364870323f;
constexpr float THR = 8.f;
constexpr int KVBLK = 64, SHM_V = 64 * 128 * 2, SHM_K = 64 * 192 * 2;
constexpr int OFF_V = 0, OFF_K = 2 * SHM_V, OFF_WS = OFF_K + 2 * SHM_K;
__device__ __forceinline__ int v_st(int k, int c) { const int kk = (k & ~0xC) | ((k & 4) << 1) | ((k & 8) >> 1); return ((kk >> 3) * 4 + (c >> 5)) * 512 + ((kk & 7) * 32 + (c & 31)) * 2; }
__device__ __forceinline__ int v_rd_base(int lane) { return ((lane & 3) << 3) | (((lane >> 2) & 3) << 6) | (((lane >> 4) & 1) << 5) | (((lane >> 5) & 1) << 8); }
constexpr int v_rd_off(int d0, int ks, int half) { return d0 * 512 + ks * 4096 + half * 2048; }
__device__ __forceinline__ int crow(int r, int hi) { return (r & 3) + 8 * (r >> 2) + 4 * hi; }
__device__ __forceinline__ int k_off(int row, int ch) { return row * 384 + (((ch & ~7) | ((ch & 7) ^ ((row >> 1) & 7))) << 4); }

__device__ __forceinline__ void partialSM(f32x16& p0, f32x16& p1, float& m_reg, float& mn, float& alpha) {
    float pmax = p0[0];
#pragma unroll
    for (int r = 1; r < 16; ++r) pmax = fmaxf(pmax, p0[r]);
#pragma unroll
    for (int r = 0; r < 16; ++r) pmax = fmaxf(pmax, p1[r]);
    { auto rr = __builtin_amdgcn_permlane32_swap(__float_as_uint(pmax), __float_as_uint(pmax), false, false);
      pmax = fmaxf(__uint_as_float(rr[0]), __uint_as_float(rr[1])); }
    constexpr float C2 = 1.4426950408889634f * SCALE;
    if (__builtin_expect(__all((pmax - m_reg) * SCALE <= THR), 1)) { mn = m_reg; alpha = 1.f; }
    else { mn = fmaxf(m_reg, pmax); alpha = __builtin_amdgcn_exp2f((m_reg - mn) * C2); m_reg = mn; }
    const float mnL = -mn * C2;
#pragma unroll
    for (int r = 0; r < 16; ++r) p0[r] = fmaf(p0[r], C2, mnL);
#pragma unroll
    for (int r = 0; r < 16; ++r) p1[r] = fmaf(p1[r], C2, mnL);
#pragma unroll
    for (int r = 0; r < 16; ++r) p0[r] = __builtin_amdgcn_exp2f(p0[r]);
}
__device__ __forceinline__ void finishSM(f32x16& p0, f32x16& p1, float alpha, float& l_reg, bf16x8& pa0, bf16x8& pa1, bf16x8& pa2, bf16x8& pa3) {
#pragma unroll
    for (int r = 0; r < 16; ++r) p1[r] = __builtin_amdgcn_exp2f(p1[r]);
    float ps = 0;
#pragma unroll
    for (int r = 0; r < 16; ++r) ps += p0[r];
#pragma unroll
    for (int r = 0; r < 16; ++r) ps += p1[r];
    { auto rr = __builtin_amdgcn_permlane32_swap(__float_as_uint(ps), __float_as_uint(ps), false, false);
      ps = __uint_as_float(rr[0]) + __uint_as_float(rr[1]); }
    l_reg = l_reg * alpha + ps;
#define PK4(P, B_, OUT) do { unsigned a0 = cvt_pk_bf16(P[B_+0], P[B_+1]), a1 = cvt_pk_bf16(P[B_+2], P[B_+3]);                          \
        unsigned b0 = cvt_pk_bf16(P[B_+4], P[B_+5]), b1 = cvt_pk_bf16(P[B_+6], P[B_+7]);                                             \
        auto r0 = __builtin_amdgcn_permlane32_swap(a0, b0, false, false); auto r1 = __builtin_amdgcn_permlane32_swap(a1, b1, false, false); \
        u32x4 w = {r0[0], r1[0], r0[1], r1[1]}; OUT = *reinterpret_cast<bf16x8*>(&w); } while (0)
    PK4(p0, 0, pa0); PK4(p0, 8, pa1); PK4(p1, 0, pa2); PK4(p1, 8, pa3);
#undef PK4
}
template <int KB>
__device__ __forceinline__ void qkt(f32x16& p0, f32x16& p1, LAS const char* K_lds, int r32, int hi, const bf16x8* qr) {
    p0 = f32x16{}; p1 = f32x16{};
    LAS const char* kb[4];
#pragma unroll
    for (int dd = 0; dd < 4; ++dd) kb[dd] = K_lds + KB * SHM_K + k_off(r32, dd * 2 + hi);
#pragma unroll
    for (int d0 = 0; d0 < 12; ++d0) { LAS const char* a = kb[d0 & 3] + (d0 >> 2) * 128;
        const bf16x8 b0 = *reinterpret_cast<LAS const bf16x8*>(a);
        const bf16x8 b1 = *reinterpret_cast<LAS const bf16x8*>(a + 32 * 384);
        p0 = __builtin_amdgcn_mfma_f32_32x32x16_bf16(b0, qr[d0], p0, 0, 0, 0);
        p1 = __builtin_amdgcn_mfma_f32_32x32x16_bf16(b1, qr[d0], p1, 0, 0, 0); }
}
template <int VB>
__device__ __forceinline__ void pv_tile(f32x16* o, unsigned vb0, bf16x8 pa0, bf16x8 pa1, bf16x8 pa2, bf16x8 pa3) {
#define TRRD(dst, off) asm volatile("ds_read_b64_tr_b16 %0, %1 offset:%2" : "=&v"(dst) : "v"(vb0), "i"(off) : "memory")
#define PV_D0(d0) do { s16x4 l0, l1, l2, l3, h0, h1, h2, h3; constexpr int b_ = VB * SHM_V + v_rd_off(d0, 0, 0); \
        TRRD(l0, b_); TRRD(h0, b_ + 2048); TRRD(l1, b_ + 4096); TRRD(h1, b_ + 6144); TRRD(l2, b_ + 8192); TRRD(h2, b_ + 10240); TRRD(l3, b_ + 12288); TRRD(h3, b_ + 14336); \
        asm volatile("s_waitcnt lgkmcnt(0)" ::: "memory"); SBAR();   \
        o[d0] = __builtin_amdgcn_mfma_f32_32x32x16_bf16(pa0, (bf16x8){l0[0], l0[1], l0[2], l0[3], h0[0], h0[1], h0[2], h0[3]}, o[d0], 0, 0, 0);   \
        o[d0] = __builtin_amdgcn_mfma_f32_32x32x16_bf16(pa1, (bf16x8){l1[0], l1[1], l1[2], l1[3], h1[0], h1[1], h1[2], h1[3]}, o[d0], 0, 0, 0);   \
        o[d0] = __builtin_amdgcn_mfma_f32_32x32x16_bf16(pa2, (bf16x8){l2[0], l2[1], l2[2], l2[3], h2[0], h2[1], h2[2], h2[3]}, o[d0], 0, 0, 0);   \
        o[d0] = __builtin_amdgcn_mfma_f32_32x32x16_bf16(pa3, (bf16x8){l3[0], l3[1], l3[2], l3[3], h3[0], h3[1], h3[2], h3[3]}, o[d0], 0, 0, 0); } while (0)
    PV_D0(0); PV_D0(1); PV_D0(2); PV_D0(3);
#undef PV_D0
#undef TRRD
}

__device__ __forceinline__ void attn_unit(LAS char* lds, int head, int qb, const bf16_t* qf, const bf16_t* kvf, const bf16_t* krr,
                                          const float* cosT, const float* sinT, bf16_t* hcat) {
    const int tid = opaque(threadIdx.x), wid = __builtin_amdgcn_readfirstlane(tid >> 6), lane = tid & 63, r32 = lane & 31, hi = lane >> 5;
    const int row_w0 = qb * 256 + wid * 32, qrow = row_w0 + r32;
    LAS char* V_lds = lds + OFF_V; LAS char* K_lds = lds + OFF_K;
    LAS float* wsf = (LAS float*)(lds + OFF_WS) + wid * 64; LAS float* li_l = wsf; LAS float* al_l = wsf + 32;
    bf16x8 qr[12];
    { const bf16_t* qp = qf + (size_t)qrow * NQF + head * 192 + hi * 8;
#pragma unroll
      for (int d0 = 0; d0 < 12; ++d0) qr[d0] = *(const bf16x8*)(qp + d0 * 16);
#pragma unroll
      for (int pp = 0; pp < 2; ++pp) {
          const int i0 = pp * 16 + hi * 8;
          const f32x4 c0 = *(const f32x4*)(cosT + (size_t)qrow * 32 + i0), c1 = *(const f32x4*)(cosT + (size_t)qrow * 32 + i0 + 4);
          const f32x4 s0 = *(const f32x4*)(sinT + (size_t)qrow * 32 + i0), s1 = *(const f32x4*)(sinT + (size_t)qrow * 32 + i0 + 4);
          const float cc[8] = {c0[0], c0[1], c0[2], c0[3], c1[0], c1[1], c1[2], c1[3]}, sn[8] = {s0[0], s0[1], s0[2], s0[3], s1[0], s1[1], s1[2], s1[3]};
          float x1[8], x2[8], y1[8], y2[8];
          unpack8(*reinterpret_cast<u32x4*>(&qr[8 + pp]), x1); unpack8(*reinterpret_cast<u32x4*>(&qr[10 + pp]), x2);
#pragma unroll
          for (int e = 0; e < 8; ++e) { y1[e] = x1[e] * cc[e] - x2[e] * sn[e]; y2[e] = x1[e] * sn[e] + x2[e] * cc[e]; }
          u32x4 w1 = pack8f(y1), w2 = pack8f(y2);
          qr[8 + pp] = *reinterpret_cast<bf16x8*>(&w1); qr[10 + pp] = *reinterpret_cast<bf16x8*>(&w2);
      } }
    const int NT = 4 * qb + 1;
    float m_reg = -1e30f, l_reg = 0; f32x16 o[4] = {};
    const int krow = tid >> 3, kc8 = tid & 7;
    const int kwr = krow * 384 + ((kc8 ^ ((krow >> 1) & 7)) << 4);
    const int sr = tid >> 4, sc = (tid & 15) * 8;
    const int vst0 = v_st(sr, sc), vst1 = v_st(32 + sr, sc);
    const unsigned vb0 = (unsigned)(uintptr_t)V_lds + (unsigned)v_rd_base(lane);
    bf16x8 sk[3], sv[2];
#define LOADT(t) do { const int kb_ = (3 + (t)) * KVBLK; const bf16_t* kp_ = kvf + (size_t)(kb_ + krow) * NKVF + head * 256 + kc8 * 8; \
        sk[0] = *(const bf16x8*)kp_; sk[1] = *(const bf16x8*)(kp_ + 64); sk[2] = *(const bf16x8*)(krr + (size_t)(kb_ + krow) * 64 + kc8 * 8); \
        sv[0] = *(const bf16x8*)(kvf + (size_t)(kb_ + sr) * NKVF + head * 256 + 128 + sc); sv[1] = *(const bf16x8*)(kvf + (size_t)(kb_ + 32 + sr) * NKVF + head * 256 + 128 + sc); } while (0)
#define WRITET(bf) do { _Pragma("unroll") for (int i = 0; i < 3; ++i) *(LAS bf16x8*)(K_lds + (bf) * SHM_K + kwr + 128 * i) = sk[i]; \
        *(LAS bf16x8*)(V_lds + (bf) * SHM_V + vst0) = sv[0]; *(LAS bf16x8*)(V_lds + (bf) * SHM_V + vst1) = sv[1]; } while (0)
#define RESC(a) do { if (__any((a) < 1.f)) { if (hi == 0) al_l[r32] = (a); asm volatile("s_waitcnt lgkmcnt(0)" ::: "memory");              \
                     _Pragma("unroll") for (int d_ = 0; d_ < 4; ++d_) _Pragma("unroll") for (int r = 0; r < 16; ++r) o[d_][r] *= al_l[crow(r, hi)]; } } while (0)
#define STEP(t, BUF) do { \
        if ((t) + 1 < NT) LOADT((t) + 1); \
        f32x16 p0, p1; float mn, alpha; bf16x8 pa0, pa1, pa2, pa3; \
        qkt<BUF>(p0, p1, K_lds, r32, hi, qr); \
        { const int kb_ = (3 + (t)) * KVBLK; \
          if (kb_ + KVBLK - 1 > row_w0 || kb_ < RFIRST) { const float NEG = -__builtin_inff(); \
            _Pragma("unroll") for (int r = 0; r < 16; ++r) { const int key0 = kb_ + crow(r, hi); \
                if (key0 > qrow || key0 < RFIRST) p0[r] = NEG; if (key0 + 32 > qrow || key0 + 32 < RFIRST) p1[r] = NEG; } } } \
        partialSM(p0, p1, m_reg, mn, alpha); \
        RESC(alpha); \
        finishSM(p0, p1, alpha, l_reg, pa0, pa1, pa2, pa3); SBAR(); \
        pv_tile<BUF>(o, vb0, pa0, pa1, pa2, pa3); \
        if ((t) + 1 < NT) WRITET((BUF) ^ 1); \
        __syncthreads(); } while (0)
    LOADT(0); WRITET(0); __syncthreads();
    for (int t = 0; t < NT; t += 2) {
        STEP(t, 0);
        if (t + 1 < NT) STEP(t + 1, 1);
    }
    if (hi == 0) li_l[r32] = l_reg; asm volatile("s_waitcnt lgkmcnt(0)" ::: "memory");
    float rli[16];
#pragma unroll
    for (int r = 0; r < 16; ++r) rli[r] = __builtin_amdgcn_rcpf(li_l[crow(r, hi)]);
    bf16_t* Ow = hcat + (size_t)row_w0 * DM + 2048 + head * 128;
#pragma unroll
    for (int r = 0; r < 16; ++r) { const int orow = crow(r, hi);
#pragma unroll
        for (int d0 = 0; d0 < 4; ++d0) { const float v = o[d0][r] * rli[r]; const float vn = __shfl_xor(v, 1);
            if ((r32 & 1) == 0 && row_w0 + orow >= RFIRST) *(unsigned*)(Ow + (size_t)orow * DM + d0 * 32 + r32) = cvt_pk_bf16(v, vn); } }
#undef LOADT
#undef WRITET
#undef RESC
#undef STEP
}
}

namespace mls {
constexpr int QP = 528, VP = 272, SP = 144;
constexpr int Q_OFF = 0, K_OFF = 33792, V_OFF = 67584, S_OFF = 84992, SC_OFF = 94208, DEN_OFF = 110592, N_OFF = 110848, GC_OFF = 112896;
__device__ __forceinline__ f32x4 mfma16(bf16x8 a, bf16x8 b, f32x4 c) { return __builtin_amdgcn_mfma_f32_16x16x32_bf16(a, b, c, 0, 0, 0); }
#define TR64(dst, addr, off) asm volatile("ds_read_b64_tr_b16 %0, %1 offset:%2" : "=&v"(dst) : "v"(addr), "i"(off) : "memory")

__device__ __forceinline__ void mlstm_unit(LAS unsigned char* lds, int h, int sl, int grp, int so, const bf16_t* qc, const bf16_t* kc, const bf16_t* z, const float* li, const float* lf, float* hm, float* cst, float* nst, unsigned* p1cnt, unsigned* tmo) {
    const int tid = opaque(threadIdx.x), wave = __builtin_amdgcn_readfirstlane(tid >> 6), lane = tid & 63, n16 = lane & 15, g = lane >> 4;
    const int tq = (lane >> 2) & 3, tp = lane & 3;
    const unsigned lbase = (unsigned)(uintptr_t)lds;
    LAS float* sc_u = (LAS float*)(lds + SC_OFF + wave * 2048); LAS float* sc_vv = sc_u + 64; LAS float* sc_wi = sc_u + 128; LAS float* sc_fl = sc_u + 192; LAS float* sc_ew = sc_u + 256;
    LAS float* den_l = (LAS float*)(lds + DEN_OFF); LAS float* nbuf = (LAS float*)(lds + N_OFF);
    const int dvb = sl * 128 + wave * 16;
    f32x4 Cacc[16];
#pragma unroll
    for (int i = 0; i < 16; ++i) Cacc[i] = (f32x4){0.f, 0.f, 0.f, 0.f};
    float m_c = 0.f;
    nbuf[tid] = 0.f;
    const int u16 = h * 4 + sl;
    const int c_beg = grp == 0 ? 3 : (grp == 1 ? 67 : (grp == 2 ? 131 : 195)), c_end = grp == 0 ? 67 : (grp == 1 ? 131 : (grp == 2 ? 195 : NCHUNK));
    float coef0 = 0.f, coef1 = 0.f, coef2 = 0.f;
    if (grp > 0) {
        LAS float* gC = (LAS float*)(lds + GC_OFF); LAS float* vmC = gC + 264;
        for (int c = 3 + wave; c < c_beg; c += 8) {
            const float li_t = li[((size_t)c * 64 + lane) * 4 + h], lf_t = lf[((size_t)c * 64 + lane) * 4 + h];
            float b = lf_t;
#pragma unroll
            for (int o = 1; o < 64; o <<= 1) { const float t_ = __shfl_up(b, o); if (lane >= o) b += t_; }
            float vm = li_t - b;
#pragma unroll
            for (int o = 1; o < 64; o <<= 1) vm = fmaxf(vm, __shfl_xor(vm, o));
            if (lane == 63) { gC[c] = b; vmC[c] = vm; }
        }
        __syncthreads();
        float m = 0.f, mS1 = 0.f, mS2 = 0.f, mS3 = 0.f, G1 = 0.f, G2 = 0.f;
        for (int c = 3; c < c_beg; ++c) { const float gg = gC[c]; m = fmaxf(gg + m, gg + vmC[c]);
            if (c >= 67 && c < 131) G1 += gg; if (c >= 131 && c < 195) G2 += gg;
            if (c == 66) mS1 = m; if (c == 130) mS2 = m; if (c == 194) mS3 = m; }
        m_c = m;
        const float P1 = fexp(G1 + mS1 - mS2), P2 = fexp(G2 + mS2 - mS3);
        if (grp == 1) { coef0 = 1.f; }
        else if (grp == 2) { coef0 = P1; coef1 = 1.f; }
        else { coef0 = P2 * P1; coef1 = P2; coef2 = 1.f; }
    }
    bf16x8 sq[4], sk[4], sv[2]; float pli, plf;
    const int srow = tid >> 5, sch = tid & 31, vrow0 = tid >> 4, vch = tid & 15;
    const bf16_t* gq = qc + (size_t)srow * 1024 + h * 256 + sch * 8; const bf16_t* gk = kc + (size_t)srow * 1024 + h * 256 + sch * 8;
    const bf16_t* gv = z + (size_t)vrow0 * NIN + ZV + h * 512 + sl * 128 + vch * 8;
    LAS unsigned char* wq = lds + Q_OFF + srow * QP + sch * 16; LAS unsigned char* wv = lds + V_OFF + vrow0 * VP + vch * 16;
#define ML_LOAD(c) do { const size_t r0_ = (size_t)(c) * 64; \
        _Pragma("unroll") for (int i = 0; i < 4; ++i) { sq[i] = *(const bf16x8*)(gq + (r0_ + 16 * i) * 1024); sk[i] = *(const bf16x8*)(gk + (r0_ + 16 * i) * 1024); } \
        sv[0] = *(const bf16x8*)(gv + r0_ * NIN); sv[1] = *(const bf16x8*)(gv + (r0_ + 32) * NIN); pli = li[(r0_ + lane) * 4 + h]; plf = lf[(r0_ + lane) * 4 + h]; } while (0)
#define ML_WRITE() do { _Pragma("unroll") for (int i = 0; i < 4; ++i) { *(LAS bf16x8*)(wq + i * 16 * QP) = sq[i]; *(LAS bf16x8*)(wq + (K_OFF - Q_OFF) + i * 16 * QP) = sk[i]; } \
        *(LAS bf16x8*)(wv) = sv[0]; *(LAS bf16x8*)(wv + 32 * VP) = sv[1]; } while (0)
    LAS const unsigned char* qrow_b = lds + Q_OFF + n16 * QP + g * 16;
    LAS const unsigned char* qsub_b = lds + Q_OFF + n16 * QP + (g >> 1) * 16 + (g & 1) * 8;
    LAS const unsigned char* srow_b = lds + S_OFF + n16 * SP + g * 16;
    const unsigned ktr_b = lbase + K_OFF + (8 * g + tq) * QP + (tp >> 1) * 16 + (tp & 1) * 8;
    const unsigned vtr_b = lbase + V_OFF + (8 * g + tq) * VP + (2 * wave + (tp >> 1)) * 16 + (tp & 1) * 8;
    if (!so && grp > 0) {
        if (tid == 0) { unsigned sp = 0;
            while (__hip_atomic_load(p1cnt, __ATOMIC_RELAXED, __HIP_MEMORY_SCOPE_AGENT) < 48u) { __builtin_amdgcn_s_sleep(8);
                if ((++sp & 255u) == 0u) { if (__hip_atomic_load(tmo, __ATOMIC_RELAXED, __HIP_MEMORY_SCOPE_AGENT)) break; if (sp > (1u << 22)) { atomicAdd(tmo, 1u); break; } } }
            __builtin_amdgcn_fence(__ATOMIC_ACQUIRE, "agent");
            asm volatile("s_waitcnt vmcnt(0)" ::: "memory"); }
        __syncthreads();
        float nacc = 0.f;
#pragma unroll
        for (int gp = 0; gp < 3; ++gp) { const float cf = gp == 0 ? coef0 : (gp == 1 ? coef1 : coef2);
            if (gp < grp) { const f32x4* src = (const f32x4*)(cst + (((size_t)gp * 16 + u16) * 512 + tid) * 64);
#pragma unroll
                for (int i = 0; i < 16; ++i) Cacc[i] += cf * src[i];
                if (tid < 256) nacc += cf * nst[((size_t)gp * 16 + u16) * 256 + tid]; } }
        if (tid < 256) nbuf[(c_beg & 1) * 256 + tid] = nacc;
    }
    ML_LOAD(c_beg); ML_WRITE(); __syncthreads();
    for (int c = c_beg; c < c_end; ++c) {
        const float li_t = pli, lf_t = plf;
        if (c + 1 < c_end) ML_LOAD(c + 1);
        const size_t r0 = (size_t)c * 64;
        float b = lf_t;
#pragma unroll
        for (int o = 1; o < 64; o <<= 1) { const float t_ = __shfl_up(b, o); if (lane >= o) b += t_; }
        const float vv = li_t - b;
        float pm = vv;
#pragma unroll
        for (int o = 1; o < 64; o <<= 1) { const float t_ = __shfl_up(pm, o); if (lane >= o) pm = fmaxf(pm, t_); }
        const float gl = __shfl(b, 63), vvmax = __shfl(pm, 63);
        const float mt_ = fmaxf(b + m_c, b + pm);
        const float u_t = b - mt_;
        const float m_next = fmaxf(gl + m_c, gl + vvmax);
        const float decay = fexp(gl + m_c - m_next);
        sc_u[lane] = u_t; sc_vv[lane] = vv; sc_wi[lane] = fexp(u_t + m_c); sc_fl[lane] = fexp(-mt_); sc_ew[lane] = fexp(gl + vv - m_next);
        LDS_WAIT();
        f32x4 acc[4];
        if (!so) {
        {
            const int tT = wave >> 1, sT0 = 2 * (wave & 1);
            f32x4 s0 = (f32x4){0.f, 0.f, 0.f, 0.f}, s1 = s0;
            if (sT0 <= tT) {
                LAS const unsigned char* ab = qrow_b + tT * 16 * QP; LAS const unsigned char* bb = qrow_b + (K_OFF - Q_OFF) + sT0 * 16 * QP;
#pragma unroll
                for (int ks = 0; ks < 8; ++ks) {
                    const bf16x8 a = *(const LAS bf16x8*)(ab + ks * 64);
                    const bf16x8 b0 = *(const LAS bf16x8*)(bb + ks * 64);
                    const bf16x8 b1 = *(const LAS bf16x8*)(bb + 16 * QP + ks * 64);
                    s0 = mfma16(a, b0, s0); s1 = mfma16(a, b1, s1);
                }
            }
#pragma unroll
            for (int jj = 0; jj < 2; ++jj) {
                const int s_ = 16 * (sT0 + jj) + n16; const float vvs = sc_vv[s_];
#pragma unroll
                for (int i = 0; i < 4; ++i) { const int t_ = 16 * tT + 4 * g + i;
                    const float sv_ = (jj == 0 ? s0[i] : s1[i]);
                    const float val = (s_ <= t_) ? sv_ * fexp(sc_u[t_] + vvs) : 0.f;
                    *(LAS unsigned short*)(lds + S_OFF + t_ * SP + s_ * 2) = f2bf(val); }
            }
        }
#pragma unroll
        for (int mt = 0; mt < 4; ++mt) acc[mt] = (f32x4){0.f, 0.f, 0.f, 0.f};
#pragma unroll
        for (int i = 0; i < 8; ++i) {
            u32x4 bw; bw.x = cvt_pk_bf16(Cacc[2 * i][0], Cacc[2 * i][1]); bw.y = cvt_pk_bf16(Cacc[2 * i][2], Cacc[2 * i][3]);
            bw.z = cvt_pk_bf16(Cacc[2 * i + 1][0], Cacc[2 * i + 1][1]); bw.w = cvt_pk_bf16(Cacc[2 * i + 1][2], Cacc[2 * i + 1][3]);
            const bf16x8 bfr = *reinterpret_cast<bf16x8*>(&bw);
#pragma unroll
            for (int mt = 0; mt < 4; ++mt) {
                const u32x2 lo = *(const LAS u32x2*)(qsub_b + mt * 16 * QP + i * 64);
                const u32x2 hi2 = *(const LAS u32x2*)(qsub_b + mt * 16 * QP + i * 64 + 32);
                u32x4 aw = (u32x4){lo.x, lo.y, hi2.x, hi2.y};
                acc[mt] = mfma16(*reinterpret_cast<bf16x8*>(&aw), bfr, acc[mt]); }
        }
#pragma unroll
        for (int mt = 0; mt < 4; ++mt)
#pragma unroll
            for (int i = 0; i < 4; ++i) acc[mt][i] *= sc_wi[16 * mt + 4 * g + i];
        __syncthreads();
        }
        LAS const float* ncur = nbuf + (c & 1) * 256; LAS float* nnext = nbuf + ((c + 1) & 1) * 256;
        if (!so) {
            const int t_ = 8 * wave + (lane >> 3), seg = lane & 7;
            float sv8[8]; unpack8(*(const LAS u32x4*)(lds + S_OFF + t_ * SP + seg * 16), sv8);
            float rsum = ((sv8[0] + sv8[1]) + (sv8[2] + sv8[3])) + ((sv8[4] + sv8[5]) + (sv8[6] + sv8[7]));
            float qn = 0.f;
#pragma unroll
            for (int cc = 0; cc < 4; ++cc) { float q8[8]; unpack8(*(const LAS u32x4*)(lds + Q_OFF + t_ * QP + (4 * seg + cc) * 16), q8);
                const f32x4 n0 = *(const LAS f32x4*)(ncur + 32 * seg + 8 * cc), n1 = *(const LAS f32x4*)(ncur + 32 * seg + 8 * cc + 4);
                qn += (q8[0] * n0[0] + q8[1] * n0[1]) + (q8[2] * n0[2] + q8[3] * n0[3]) + (q8[4] * n1[0] + q8[5] * n1[1]) + (q8[6] * n1[2] + q8[7] * n1[3]); }
            rsum += __shfl_xor(rsum, 1); rsum += __shfl_xor(rsum, 2); rsum += __shfl_xor(rsum, 4);
            qn += __shfl_xor(qn, 1); qn += __shfl_xor(qn, 2); qn += __shfl_xor(qn, 4);
            if (seg == 0) den_l[t_] = 1.0f / fmaxf(fabsf(sc_wi[t_] * qn + rsum), sc_fl[t_]);
        }
        if (tid < 256) { float nn = decay * ncur[tid]; LAS const unsigned char* kp = lds + K_OFF + tid * 2;
#pragma unroll 8
            for (int s_ = 0; s_ < 64; ++s_) nn += sc_ew[s_] * bf2f(*(const LAS unsigned short*)(kp + s_ * QP));
            nnext[tid] = nn; }
        bf16x8 vB[2];
        { s16x4 l0, h0, l1, h1;
          TR64(l0, vtr_b, 0); TR64(h0, vtr_b, 4 * VP); TR64(l1, vtr_b, 32 * VP); TR64(h1, vtr_b, 36 * VP); LDS_WAIT(); SBAR();
          vB[0] = (bf16x8){l0[0], l0[1], l0[2], l0[3], h0[0], h0[1], h0[2], h0[3]}; vB[1] = (bf16x8){l1[0], l1[1], l1[2], l1[3], h1[0], h1[1], h1[2], h1[3]}; }
        if (!so) {
#pragma unroll
        for (int ks = 0; ks < 2; ++ks)
#pragma unroll
            for (int mt = 0; mt < 4; ++mt) {
                const bf16x8 a = *(const LAS bf16x8*)(srow_b + mt * 16 * SP + ks * 64);
                acc[mt] = mfma16(a, vB[ks], acc[mt]); }
        __syncthreads();
        { float* hp = hm + (r0 + 4 * g) * 2048 + h * 512 + dvb + n16;
#pragma unroll
          for (int mt = 0; mt < 4; ++mt)
#pragma unroll
            for (int i = 0; i < 4; ++i) { const int t_ = 16 * mt + 4 * g + i;
                hp[(size_t)(16 * mt + i) * 2048] = acc[mt][i] * den_l[t_]; } }
        }
        bf16x8 vBs[2];
#pragma unroll
        for (int ks = 0; ks < 2; ++ks) { float f8[8]; unpack8(*reinterpret_cast<u32x4*>(&vB[ks]), f8);
#pragma unroll
            for (int j = 0; j < 8; ++j) f8[j] *= sc_ew[32 * ks + 8 * g + j];
            u32x4 w = pack8f(f8); vBs[ks] = *reinterpret_cast<bf16x8*>(&w); }
#pragma unroll
        for (int i = 0; i < 16; ++i) Cacc[i] *= decay;
#define ML_UPD(ks, ib) do { s16x4 l0, h0, l1, h1, l2, h2, l3, h3; constexpr int o_ = (ks) * 32 * QP + (ib) * 32; \
            TR64(l0, ktr_b, o_); TR64(h0, ktr_b, o_ + 4 * QP); TR64(l1, ktr_b, o_ + 32); TR64(h1, ktr_b, o_ + 32 + 4 * QP); \
            TR64(l2, ktr_b, o_ + 64); TR64(h2, ktr_b, o_ + 64 + 4 * QP); TR64(l3, ktr_b, o_ + 96); TR64(h3, ktr_b, o_ + 96 + 4 * QP); LDS_WAIT(); SBAR(); \
            Cacc[(ib) + 0] = mfma16((bf16x8){l0[0], l0[1], l0[2], l0[3], h0[0], h0[1], h0[2], h0[3]}, vBs[ks], Cacc[(ib) + 0]); \
            Cacc[(ib) + 1] = mfma16((bf16x8){l1[0], l1[1], l1[2], l1[3], h1[0], h1[1], h1[2], h1[3]}, vBs[ks], Cacc[(ib) + 1]); \
            Cacc[(ib) + 2] = mfma16((bf16x8){l2[0], l2[1], l2[2], l2[3], h2[0], h2[1], h2[2], h2[3]}, vBs[ks], Cacc[(ib) + 2]); \
            Cacc[(ib) + 3] = mfma16((bf16x8){l3[0], l3[1], l3[2], l3[3], h3[0], h3[1], h3[2], h3[3]}, vBs[ks], Cacc[(ib) + 3]); } while (0)
        ML_UPD(0, 0); ML_UPD(0, 4); ML_UPD(0, 8); ML_UPD(0, 12); ML_UPD(1, 0); ML_UPD(1, 4); ML_UPD(1, 8); ML_UPD(1, 12);
#undef ML_UPD
        m_c = m_next;
        __syncthreads();
        if (c + 1 < c_end) ML_WRITE();
        __syncthreads();
    }
    if (so) {
        f32x4* dst = (f32x4*)(cst + (((size_t)grp * 16 + u16) * 512 + tid) * 64);
#pragma unroll
        for (int i = 0; i < 16; ++i) dst[i] = Cacc[i];
        if (tid < 256) nst[((size_t)grp * 16 + u16) * 256 + tid] = nbuf[(c_end & 1) * 256 + tid];
        asm volatile("s_waitcnt vmcnt(0)" ::: "memory");
        __syncthreads();
        if (tid == 0) { __builtin_amdgcn_fence(__ATOMIC_RELEASE, "agent"); asm volatile("s_waitcnt vmcnt(0)" ::: "memory");
            __hip_atomic_fetch_add(p1cnt, 1u, __ATOMIC_RELAXED, __HIP_MEMORY_SCOPE_AGENT); }
    }
#undef ML_LOAD
#undef ML_WRITE
}
#undef TR64
}

constexpr int LDS_BYTES = 147456;
constexpr int MISC_OFF = 131072 + 4096;
constexpr int NPHASE = 21;
struct Args { Ptrs p; int ph_lo, ph_hi; };

__global__ void __launch_bounds__(512, 2) fwd_kernel(Args args) {
    extern __shared__ __attribute__((aligned(16))) unsigned char lds_raw[];
    LAS unsigned char* lds = (LAS unsigned char*)lds_raw;
    volatile LAS unsigned* MISC = (volatile LAS unsigned*)(lds + MISC_OFF);
    const int tid = threadIdx.x, lane = tid & 63, wave = __builtin_amdgcn_readfirstlane(tid >> 6);
    const int G = gridDim.x; const int bx = blockIdx.x;
    const int gw = bx * 8 + wave, NGW = G * 8;
    const Ptrs& P = args.p;
    unsigned char* ws = P.ws;
    unsigned* ctl = (unsigned*)(ws + WS_CTL);
    if (tid < 64) MISC[tid] = 0u;
    __syncthreads();
#if MK_PER_PHASE
    XcdBarrier bar; bar.bar = ctl + CW_BAR; bar.x = 0; bar.st = nullptr;
#define GRID_BAR() do { } while (0)
#else
    XcdBarrier bar = xcd_barrier_post(ctl + CW_BAR, MISC + 8);
#define GRID_BAR() xcd_barrier(bar)
#endif
    const int lo = args.ph_lo, hi = args.ph_hi;
#ifndef PH_MASK
#define PH_MASK 0xFFFF
#endif
#define PHON(t) (((PH_MASK) >> (t)) & 1)
#ifndef DUP_MASK
#define DUP_MASK 0
#endif
#define NREP(t) ((((DUP_MASK) >> (t)) & 1) ? 2 : 1)
#define IN(k) (lo <= (k) && (k) < hi)
#define BOTH(k) (IN(k) && IN((k) + 1))

    float* hres = (float*)(ws + WS_HRES); bf16_t* u = (bf16_t*)(ws + WS_U); bf16_t* z = (bf16_t*)(ws + WS_Z);
    bf16_t* qc = (bf16_t*)(ws + WS_QC); bf16_t* kc = (bf16_t*)(ws + WS_KC); bf16_t* cqn = (bf16_t*)(ws + WS_CQN); bf16_t* ckvn = (bf16_t*)(ws + WS_CKVN);
    bf16_t* krr = (bf16_t*)(ws + WS_KRR); bf16_t* qf = (bf16_t*)(ws + WS_QF); bf16_t* kvf = (bf16_t*)(ws + WS_KVF); float* hm = (float*)(ws + WS_HM);
    bf16_t* hcat = (bf16_t*)(ws + WS_HCAT); bf16_t* mix = z; bf16_t* act = z; bf16_t* yb = kvf;
    float* cosT = (float*)(ws + WS_COS); float* sinT = (float*)(ws + WS_SIN); float* li = (float*)(ws + WS_LI); float* lf = (float*)(ws + WS_LF);

    if (PHON(0) && IN(0)) { for (int rep = 0; rep < NREP(0); ++rep) { p_prologue(P, lds, gw, NGW, wave, lane); if (BOTH(0)) GRID_BAR(); } }

#pragma unroll 1
    for (int l = 0; l < 2; ++l) {
        const int pb = 1 + 10 * l;
        if (PHON(1) && IN(pb + 0)) { for (int rep = 0; rep < NREP(1); ++rep) {
            pg8::Gemm g{u, w_ptr(ws, l, 0), R, NIN, DM, DM, DM}; pg8::StaticOrder S; S.init(R, NIN, G, bx);
            pg8::EpiBf16 E{z, NIN};
            pg8::gemm_phase<pg8::EpiBf16>(lds, g, S, E);
            if (BOTH(pb + 0)) GRID_BAR();
        } }
        if (PHON(2) && IN(pb + 1)) { for (int rep = 0; rep < NREP(2); ++rep) {
            p_prep(z, P.in[4] + (size_t)l * 4 * 2048, P.in[5] + l * 8, P.in[7] + (size_t)l * QL, P.in[9] + (size_t)l * KVL, cosT, sinT, qc, kc, li, lf, cqn, ckvn, krr, gw, NGW, lane);
            if (BOTH(pb + 1)) GRID_BAR();
        } }
        if (PHON(3) && IN(pb + 2)) { for (int rep = 0; rep < NREP(3); ++rep) {
#pragma unroll 1
            for (int gi = 0; gi < 2; ++gi) {
                const int Kg = gi ? KVL : QL, Ng = gi ? NKVF : NQF; const bf16_t* Ag = gi ? ckvn : cqn; bf16_t* Og = gi ? kvf : qf;
                pg8::Gemm g{Ag + (size_t)256 * Kg, w_ptr(ws, l, gi ? 2 : 1), SEQ, Ng, Kg, Kg, Kg};
                pg8::StaticOrder S; S.init(SEQ, Ng, G, bx);
                pg8::EpiBf16 E{Og + (size_t)256 * Ng, Ng}; pg8::gemm_phase<pg8::EpiBf16>(lds, g, S, E);
                __syncthreads();
                thin_gemm16(lds, Ag + (size_t)RFIRST * Kg, Kg, w_ptr(ws, l, gi ? 2 : 1), Kg, Kg, Ng, Og + (size_t)RFIRST * Ng, Ng, bx, G);
                __syncthreads();
            }
            if (BOTH(pb + 2)) GRID_BAR();
        } }
        if (PHON(4) && IN(pb + 3)) { for (int rep = 0; rep < NREP(4); ++rep) {
            unsigned* qhead = ctl + CW_Q + 64 * l + 1024 * rep;
            constexpr int NUNITS = 48 + 64 + NQB * 16;
            unsigned* p1cnt = ctl + CW_P1 + 64 * l + 1024 * rep; float* cst = (float*)(ws + WS_CST); float* nst = (float*)(ws + WS_NST);
            for (;;) {
                __syncthreads();
                if (tid == 0) MISC[0] = __hip_atomic_fetch_add(qhead, 1u, __ATOMIC_RELAXED, __HIP_MEMORY_SCOPE_AGENT);
                __syncthreads();
                const int un = (int)MISC[0];
                if (un >= NUNITS) break;
                if (un < 112) { if (!PHON(16) && !(rep == 1 && PHON(18))) { const int so = un < 48, v_ = so ? un : un - 48;
                    mls::mlstm_unit(lds, (v_ & 15) >> 2, v_ & 3, v_ >> 4, so, qc, kc, z, li, lf, hm, cst, nst, p1cnt, ctl + CW_BAR + XB_TMO); } }
                else if (!PHON(17) && !(rep == 1 && PHON(19))) { const int i = un - 112; att::attn_unit((LAS char*)lds, i & 15, (NQB - 1) - (i >> 4), qf, kvf, krr, cosT, sinT, hcat); }
            }
            if (BOTH(pb + 3)) GRID_BAR();
        } }
        if (PHON(5) && IN(pb + 4)) { for (int rep = 0; rep < NREP(5); ++rep) {
            p_hcat(hm, z, P.in[6] + (size_t)l * 2048, hcat, gw, NGW, lane);
            if (BOTH(pb + 4)) GRID_BAR();
        } }
        if (PHON(6) && IN(pb + 5)) { for (int rep = 0; rep < NREP(6); ++rep) {
            pg8::Gemm g{hcat + (size_t)256 * DM, w_ptr(ws, l, 3), SEQ, DM, DM, DM, DM}; pg8::StaticOrder S; S.init(SEQ, DM, G, bx);
            pg8::EpiBf16 E{mix + (size_t)256 * DM, DM}; pg8::gemm_phase<pg8::EpiBf16>(lds, g, S, E);
            __syncthreads();
            thin_gemm16(lds, hcat + (size_t)RFIRST * DM, DM, w_ptr(ws, l, 3), DM, DM, DM, mix + (size_t)RFIRST * DM, DM, bx, G);
            if (BOTH(pb + 5)) GRID_BAR();
        } }
        if (PHON(7) && IN(pb + 6)) {
            p_resnorm(mix, hres, P.in[12] + (size_t)l * DM, P.in[13] + (size_t)l * DM, u, nullptr, gw, NGW, lane);
            if (BOTH(pb + 6)) GRID_BAR();
        }
        if (PHON(8) && IN(pb + 7)) { for (int rep = 0; rep < NREP(8); ++rep) {
            pg8::Gemm g{u, w_ptr(ws, l, 4), R, NGU, DM, DM, DM}; pg8::StaticOrder S; S.init(R, NGU, G, bx);
            pg8::EpiSwiGLU E{act, DFF}; pg8::gemm_phase<pg8::EpiSwiGLU>(lds, g, S, E);
            if (BOTH(pb + 7)) GRID_BAR();
        } }
        if (PHON(9) && IN(pb + 8)) { for (int rep = 0; rep < NREP(9); ++rep) {
            pg8::Gemm g{act + (size_t)256 * DFF, w_ptr(ws, l, 5), SEQ, DM, DFF, DFF, DFF}; pg8::StaticOrder S; S.init(SEQ, DM, G, bx);
            pg8::EpiBf16 E{yb + (size_t)256 * DM, DM}; pg8::gemm_phase<pg8::EpiBf16>(lds, g, S, E);
            __syncthreads();
            thin_gemm16(lds, act + (size_t)RFIRST * DFF, DFF, w_ptr(ws, l, 5), DFF, DFF, DM, yb + (size_t)RFIRST * DM, DM, bx, G);
            if (BOTH(pb + 8)) GRID_BAR();
        } }
        if (PHON(10) && IN(pb + 9)) {
            if (l == 0) p_resnorm(yb, hres, P.in[16], P.in[2] + DM, u, nullptr, gw, NGW, lane);
            else p_resnorm(yb, hres, P.in[16] + DM, nullptr, nullptr, P.out, gw, NGW, lane);
            if (BOTH(pb + 9)) GRID_BAR();
        }
    }
#undef IN
#undef BOTH
}

extern "C" void kernel_launch(void* const* d_in, const int* in_sizes, int n_in, void* d_out, int out_size, void* d_ws, size_t ws_size, hipStream_t stream) {
    static int grid = 0;
    if (grid == 0) {
        if (n_in != 17 || out_size != SEQ * DM || ws_size < WS_END) { fprintf(stderr, "kernel_launch: unexpected shapes (n_in %d, out %d, ws %zu < %zu)\n", n_in, out_size, ws_size, (size_t)WS_END); grid = -1; return; }
        int dev = 0, cus = 0, per_cu = 0;
        if (hipGetDevice(&dev) != hipSuccess || hipDeviceGetAttribute(&cus, hipDeviceAttributeMultiprocessorCount, dev) != hipSuccess) { grid = -1; return; }
        if (hipFuncSetAttribute((const void*)fwd_kernel, hipFuncAttributeMaxDynamicSharedMemorySize, LDS_BYTES) != hipSuccess) { fprintf(stderr, "kernel_launch: hipFuncSetAttribute failed\n"); grid = -1; return; }
        if (hipOccupancyMaxActiveBlocksPerMultiprocessor(&per_cu, (const void*)fwd_kernel, 512, LDS_BYTES) != hipSuccess || per_cu < 1) fprintf(stderr, "kernel_launch: occupancy query reports %d\n", per_cu);
        (void)hipGetLastError();
        grid = cus;
    }
    if (grid < 0) return;
    (void)hipMemsetAsync((char*)d_ws + WS_CTL, 0, CTL_BYTES, stream);
    Args a{};
    for (int i = 0; i < 17; ++i) a.p.in[i] = (const float*)d_in[i];
    a.p.out = (float*)d_out; a.p.ws = (unsigned char*)d_ws;
#if MK_PER_PHASE
    for (int ph = 0; ph < NPHASE; ++ph) { a.ph_lo = ph; a.ph_hi = ph + 1; hipLaunchKernelGGL(fwd_kernel, dim3(grid), dim3(512), LDS_BYTES, stream, a); }
#else
    a.ph_lo = 0; a.ph_hi = NPHASE;
    hipLaunchKernelGGL(fwd_kernel, dim3(grid), dim3(512), LDS_BYTES, stream, a);
#endif
}
```

```cpp
#include <hip/hip_runtime.h>
#include <cstdio>
#include <cstdint>

#ifndef MK_PER_PHASE
#define MK_PER_PHASE 0
#endif

#define LAS __attribute__((address_space(3)))
typedef unsigned short bf16_t;
typedef short bf16x8 __attribute__((ext_vector_type(8)));
typedef short s16x4 __attribute__((ext_vector_type(4)));
typedef float f32x4 __attribute__((ext_vector_type(4)));
typedef float f32x16 __attribute__((ext_vector_type(16)));
typedef unsigned u32x4 __attribute__((ext_vector_type(4)));
typedef unsigned u32x2 __attribute__((ext_vector_type(2)));

constexpr int DM = 4096, SEQ = 16384, NMETA = 16;
constexpr int RFIRST = 240;
constexpr int R = 16640;
constexpr int NIN = 8448;
constexpr int ZQ = 0, ZK = 1024, ZV = 2048, ZO = 4096, ZCQ = 6144, ZCKV = 7680, ZKR = 8192, ZGI = 8256, ZGF = 8260;
constexpr int NIN_SRC = 8264;
constexpr int QL = 1536, KVL = 512, NQF = 3072, NKVF = 4096;
constexpr int DFF = 11008, NGU = 22016;
constexpr float EPS = 1e-6f;
constexpr int NCHUNK = R / 64;
constexpr int NQB = R / 256;

constexpr size_t MiB = 1u << 20;
constexpr size_t WS_CTL = 0, CTL_BYTES = 1 * MiB;
constexpr size_t WS_COS = 2 * MiB, WS_SIN = 5 * MiB;
constexpr size_t WS_LI = 8 * MiB, WS_LF = 9 * MiB;
constexpr size_t SZ_WIN = (size_t)NIN * DM * 2, SZ_WUQ = (size_t)NQF * QL * 2, SZ_WUKV = (size_t)NKVF * KVL * 2,
                 SZ_WOUT = (size_t)DM * DM * 2, SZ_WGU = (size_t)NGU * DM * 2, SZ_WDN = (size_t)DM * DFF * 2;
constexpr size_t SZ_WL = SZ_WIN + SZ_WUQ + SZ_WUKV + SZ_WOUT + SZ_WGU + SZ_WDN;
constexpr size_t WS_W = 16 * MiB;
constexpr size_t WS_HRES = WS_W + 2 * SZ_WL;
constexpr size_t WS_U = WS_HRES + (size_t)R * DM * 4;
constexpr size_t WS_Z = WS_U + (size_t)R * DM * 2;
constexpr size_t WS_QC = WS_Z + (size_t)R * NIN * 2;
constexpr size_t WS_KC = WS_QC + (size_t)R * 1024 * 2;
constexpr size_t WS_CQN = WS_KC + (size_t)R * 1024 * 2;
constexpr size_t WS_CKVN = WS_CQN + (size_t)R * QL * 2;
constexpr size_t WS_KRR = WS_CKVN + (size_t)R * KVL * 2;
constexpr size_t WS_QF = WS_KRR + (size_t)R * 64 * 2;
constexpr size_t WS_KVF = WS_QF + (size_t)R * NQF * 2;
constexpr size_t WS_HM = WS_KVF + (size_t)R * NKVF * 2;
constexpr size_t WS_HCAT = WS_HM + (size_t)R * 2048 * 4;
constexpr size_t WS_CST = WS_HCAT + (size_t)R * DM * 2;
constexpr size_t WS_NST = WS_CST + (size_t)3 * 16 * 512 * 64 * 4;
constexpr size_t WS_VT = WS_NST + (size_t)3 * 16 * 256 * 4;
constexpr size_t WS_END = WS_VT + (size_t)16 * 260 * 16384;
constexpr size_t WS_KT = WS_KVF;
static_assert((size_t)R * DFF * 2 <= WS_CKVN - WS_Z, "act overlay fits in z|qc|kc|cqn");
constexpr int CW_BAR = 4096;
constexpr int CW_Q = 16384;
constexpr int CW_QA = 49152;
constexpr int CW_P1 = 32768;

__device__ __forceinline__ float bf2f(unsigned short b) { return __uint_as_float(((unsigned)b) << 16); }
__device__ __forceinline__ float bflo(unsigned w) { return __uint_as_float(w << 16); }
__device__ __forceinline__ float bfhi(unsigned w) { return __uint_as_float(w & 0xffff0000u); }
__device__ __forceinline__ unsigned cvt_pk_bf16(float lo, float hi) { unsigned r; asm volatile("v_cvt_pk_bf16_f32 %0, %1, %2" : "=v"(r) : "v"(lo), "v"(hi)); return r; }
__device__ __forceinline__ unsigned short f2bf(float f) { return (unsigned short)(cvt_pk_bf16(f, 0.f) & 0xffffu); }
__device__ __forceinline__ float wave_sum(float v) {
#pragma unroll
    for (int o = 1; o < 64; o <<= 1) v += __shfl_xor(v, o);
    return v;
}
__device__ __forceinline__ float fexp(float x) { return __builtin_amdgcn_exp2f(x * 1.4426950408889634f); }
__device__ __forceinline__ int opaque(int x) { asm volatile("" : "+v"(x)); return x; }
#define LDS_WAIT() asm volatile("s_waitcnt lgkmcnt(0)" ::: "memory")
#define SBAR() __builtin_amdgcn_sched_barrier(0)

#define XB_TMO      128
#define XB_XCNT(j)  (256  + 64 * (j))
#define XB_XSUB(j)  (1280 + 64 * (j))
#define XB_XGEN(j)  (2304 + 64 * (j))
#define XB_TOP      3328
#define XB_TOPGEN   3392
#define XCD_BAR_WORDS 3456
#define XB_SPIN_CAP (1u << 20)

__device__ __forceinline__ unsigned xb_ld(unsigned* p)              { return __hip_atomic_load(p, __ATOMIC_RELAXED, __HIP_MEMORY_SCOPE_AGENT); }
__device__ __forceinline__ unsigned xb_add(unsigned* p, unsigned v) { return __hip_atomic_fetch_add(p, v, __ATOMIC_RELAXED, __HIP_MEMORY_SCOPE_AGENT); }
__device__ __forceinline__ unsigned xb_xcc_id() { return (unsigned)__builtin_amdgcn_s_getreg((3 << 11) | 20) & 0xFu; }
#define XB_SPIN(cond, bar) do { unsigned _sp = 0; while (cond) { __builtin_amdgcn_s_sleep(1); \
    if ((++_sp & 255u) == 0u) { if (xb_ld(&(bar)[XB_TMO])) break; if (_sp > XB_SPIN_CAP) { atomicAdd(&(bar)[XB_TMO], 1u); break; } } } } while (0)

struct XcdBarrier { unsigned* bar; unsigned x; volatile LAS unsigned* st; };

__device__ __forceinline__ XcdBarrier xcd_barrier_post(unsigned* bar, volatile LAS unsigned* st) {
    XcdBarrier b; b.bar = bar; b.x = xb_xcc_id(); b.st = st;
    if (threadIdx.x == 0) (void)xb_add(&bar[XB_XCNT(b.x)], 1u);
    return b;
}
__device__ __forceinline__ void xcd_barrier_complete(unsigned* bar, unsigned x, unsigned& nloc, unsigned& nx) {
    const unsigned G = gridDim.x * gridDim.y * gridDim.z;
    unsigned sum, cnt, mine, sp = 0u;
    for (;;) {
        sum = 0u; cnt = 0u; mine = 0u;
#pragma unroll
        for (unsigned j = 0; j < 16; ++j) { const unsigned c = xb_ld(&bar[XB_XCNT(j)]); sum += c; cnt += (c > 0u) ? 1u : 0u; mine = (j == x) ? c : mine; }
        if (sum == G) break;
        __builtin_amdgcn_s_sleep(1);
        if ((++sp & 255u) == 0u) { if (xb_ld(&bar[XB_TMO])) break; if (sp > XB_SPIN_CAP) { atomicAdd(&bar[XB_TMO], 1u); break; } }
    }
    nloc = mine > 0u ? mine : 1u; nx = cnt > 0u ? cnt : 1u;
}
__device__ __forceinline__ void xcd_barrier(const XcdBarrier& b) {
    asm volatile("s_waitcnt vmcnt(0)" ::: "memory");
    __syncthreads();
    if (threadIdx.x == 0) {
        unsigned* bar = b.bar;
        __builtin_amdgcn_s_waitcnt(0);
        unsigned nloc = b.st[0], nx = b.st[1];
        if (nloc == 0u) { xcd_barrier_complete(bar, b.x, nloc, nx); b.st[0] = nloc; b.st[1] = nx; }
        const unsigned old = xb_add(&bar[XB_XSUB(b.x)], 1u);
        const unsigned gen = old / nloc;
        if (old + 1u == (gen + 1u) * nloc) {
            __builtin_amdgcn_fence(__ATOMIC_RELEASE, "agent");
            asm volatile("s_waitcnt vmcnt(0)" ::: "memory");
            const unsigned og = xb_add(&bar[XB_TOP], 1u);
            const unsigned tg = og / nx;
            if (og + 1u == (tg + 1u) * nx) xb_add(&bar[XB_TOPGEN], 1u);
            else XB_SPIN(xb_ld(&bar[XB_TOPGEN]) == tg, bar);
            __builtin_amdgcn_fence(__ATOMIC_ACQUIRE, "agent");
            xb_add(&bar[XB_XGEN(b.x)], 1u);
            asm volatile("s_waitcnt vmcnt(0)" ::: "memory");
        } else {
            XB_SPIN(xb_ld(&bar[XB_XGEN(b.x)]) == gen, bar);
            __builtin_amdgcn_fence(__ATOMIC_ACQUIRE, "agent");
            asm volatile("s_waitcnt vmcnt(0)" ::: "memory");
        }
    }
    __syncthreads();
}


constexpr int KT_BYTES = 24576, VT_BYTES = 16384, NTILE = 260;
__device__ __forceinline__ int kt_off(int row, int ch) { return row * 384 + (((ch & ~7) | ((ch & 7) ^ ((row >> 1) & 7))) << 4); }
__device__ __forceinline__ int vt_off(int k, int c) { const int kk = (k & ~0xC) | ((k & 4) << 1) | ((k & 8) >> 1); return ((kk >> 3) * 4 + (c >> 5)) * 512 + ((kk & 7) * 32 + (c & 31)) * 2; }
__device__ __forceinline__ unsigned char* kv_dst(unsigned char* kt, unsigned char* vt, int head, int row, int cl) {
    const int tile = row >> 6, rl = row & 63;
    return cl < 128 ? kt + ((size_t)head * NTILE + tile) * KT_BYTES + kt_off(rl, cl >> 3)
                    : vt + ((size_t)head * NTILE + tile) * VT_BYTES + vt_off(rl, cl - 128);
}

namespace pg8 {
constexpr int BM = 256, BK = 64, HALF = 128, HTB = HALF * BK * 2, STAGE_BYTES = 8 * HTB, NXCD = 8, WGM = 8;
__device__ __forceinline__ int lds_byte(int r, int c) { const int st = (r >> 4) * 2 + (c >> 5), rr = r & 15, cc = c & 31, ob = rr * 64 + cc * 2; return st * 1024 + (ob ^ (((ob >> 9) & 1) << 5)); }
__device__ __forceinline__ void stage_rc(int b, int& R_, int& C) { const int st = b / 1024, sb = b % 1024, swz = sb ^ (((sb >> 9) & 1) << 5); R_ = (st >> 1) * 16 + swz / 64; C = (st & 1) * 32 + (swz % 64) / 2; }
__device__ __forceinline__ int perm32(int rho) { const int n = rho >> 4, i = rho & 15; return 8 * (i >> 2) + 4 * n + (i & 3); }
struct Unit { int pm, pn; };
struct Gemm { const bf16_t* A; const bf16_t* Bt; int M, N, K, lda, ldb; };
struct StaticOrder {
    int nM, nN, nwg, G, c;
    __device__ void init(int M, int N, int G_, int c_) { nM = M / BM; nN = N / BM; nwg = nM * nN; G = G_; c = c_; }
    __device__ bool next(int i, Unit& u) const {
        const long L = (long)i * G + c; if (L >= nwg) return false;
        int wgid = (int)L; { const int q = nwg / NXCD, r = nwg % NXCD, xcd = wgid % NXCD, off = wgid / NXCD; wgid = (xcd < r ? xcd * (q + 1) : r * (q + 1) + (xcd - r) * q) + off; }
        const int nig = WGM * nN, gid = wgid / nig, fm = gid * WGM, gsz = (nM - fm) < WGM ? (nM - fm) : WGM;
        u.pm = fm + ((wgid % nig) % gsz); u.pn = (wgid % nig) / gsz; return true;
    }
};
struct EpiBf16 {
    static constexpr bool PERM = true;
    bf16_t* O; int ldc;
    __device__ __forceinline__ void operator()(const f32x4 (&acc)[2][2][4][2], const Unit& u, int wr, int wc, int fr, int fq) const {
        const int row0 = u.pm * BM + wr * 64 + fr, col0 = u.pn * BM + wc * 32 + 8 * fq;
#pragma unroll
        for (int ai = 0; ai < 2; ++ai)
#pragma unroll
            for (int m = 0; m < 4; ++m) { bf16_t* rowp = O + (size_t)(row0 + ai * HALF + m * 16) * ldc + col0;
#pragma unroll
                for (int bj = 0; bj < 2; ++bj) { const f32x4 v0 = acc[ai][bj][m][0], v1 = acc[ai][bj][m][1];
                    u32x4 w; w.x = cvt_pk_bf16(v0[0], v0[1]); w.y = cvt_pk_bf16(v0[2], v0[3]); w.z = cvt_pk_bf16(v1[0], v1[1]); w.w = cvt_pk_bf16(v1[2], v1[3]);
                    *(u32x4*)(rowp + bj * HALF) = w; } }
    }
};
struct EpiKV {
    static constexpr bool PERM = true;
    unsigned char* kt; unsigned char* vt; int row_off;
    __device__ __forceinline__ void operator()(const f32x4 (&acc)[2][2][4][2], const Unit& u, int wr, int wc, int fr, int fq) const {
        const int row0 = row_off + u.pm * BM + wr * 64 + fr, cl0 = wc * 32 + 8 * fq;
#pragma unroll
        for (int ai = 0; ai < 2; ++ai)
#pragma unroll
            for (int m = 0; m < 4; ++m) { const int row = row0 + ai * HALF + m * 16;
#pragma unroll
                for (int bj = 0; bj < 2; ++bj) { const f32x4 v0 = acc[ai][bj][m][0], v1 = acc[ai][bj][m][1];
                    u32x4 w; w.x = cvt_pk_bf16(v0[0], v0[1]); w.y = cvt_pk_bf16(v0[2], v0[3]); w.z = cvt_pk_bf16(v1[0], v1[1]); w.w = cvt_pk_bf16(v1[2], v1[3]);
                    *(u32x4*)kv_dst(kt, vt, u.pn, row, bj * HALF + cl0) = w; } }
    }
};
__device__ __forceinline__ float silu_mul(float g, float u) { return g * u * __builtin_amdgcn_rcpf(1.0f + __builtin_amdgcn_exp2f(-g * 1.4426950408889634f)); }
struct EpiSwiGLU {
    static constexpr bool PERM = true;
    bf16_t* O; int ldc;
    __device__ __forceinline__ void operator()(const f32x4 (&acc)[2][2][4][2], const Unit& u, int wr, int wc, int fr, int fq) const {
        const int row0 = u.pm * BM + wr * 64 + fr, col0 = u.pn * HALF + wc * 32 + 8 * fq;
#pragma unroll
        for (int ai = 0; ai < 2; ++ai)
#pragma unroll
            for (int m = 0; m < 4; ++m) { bf16_t* rowp = O + (size_t)(row0 + ai * HALF + m * 16) * ldc + col0;
                const f32x4 g0 = acc[ai][0][m][0], g1 = acc[ai][0][m][1], u0 = acc[ai][1][m][0], u1 = acc[ai][1][m][1];
                u32x4 w; w.x = cvt_pk_bf16(silu_mul(g0[0], u0[0]), silu_mul(g0[1], u0[1])); w.y = cvt_pk_bf16(silu_mul(g0[2], u0[2]), silu_mul(g0[3], u0[3]));
                w.z = cvt_pk_bf16(silu_mul(g1[0], u1[0]), silu_mul(g1[1], u1[1])); w.w = cvt_pk_bf16(silu_mul(g1[2], u1[2]), silu_mul(g1[3], u1[3]));
                *(u32x4*)rowp = w; }
    }
};

template <class Epi>
__device__ __forceinline__ void gemm_phase(LAS unsigned char* lds, const Gemm g, const StaticOrder& S, const Epi& E) {
    const int tid = opaque(threadIdx.x), wid = __builtin_amdgcn_readfirstlane(tid >> 6), lane = tid & 63, wr = wid >> 2, wc = wid & 3, fr = lane & 15, fq = lane >> 4;
    const int K = g.K, nt = K / BK;
    unsigned voffA[2], voffB[2];
#pragma unroll
    for (int i = 0; i < 2; ++i) { int R_, C; stage_rc(tid * 16 + i * 8192, R_, C); const int Rb = Epi::PERM ? ((R_ & ~31) + perm32(R_ & 31)) : R_;
        voffA[i] = (unsigned)(R_ * g.lda + C) * 2u; voffB[i] = (unsigned)(Rb * g.ldb + C) * 2u; }
    const size_t kstep = (size_t)(BK * 2);
    const size_t hstepA = (size_t)HALF * g.lda * 2, hstepB = (size_t)HALF * g.ldb * 2;
    const size_t tstepA = 2 * hstepA, tstepB = 2 * hstepB;
    const unsigned ldsw = (unsigned)wid * 1024u;
    const int aoff = lds_byte(wr * 64 + fr, fq * 8), boff = lds_byte(wc * 32 + fr, fq * 8);
#define PG8_SA(b, h) (((b) * 2 + (h)) * HTB)
#define PG8_SB(b, h) ((4 + (b) * 2 + (h)) * HTB)
#define PG8_STAGE(bufoff, gbase, voff) do { _Pragma("unroll") for (int _i = 0; _i < 2; ++_i) \
        __builtin_amdgcn_global_load_lds((const unsigned*)((const char*)(gbase) + (voff)[_i]), (LAS unsigned*)(lds + (bufoff) + ldsw + _i * 8192), 16, 0, 0); } while (0)
#define PG8_LDA(dst, b, h) do { _Pragma("unroll") for (int m = 0; m < 4; ++m) _Pragma("unroll") for (int k = 0; k < 2; ++k) dst[m][k] = *(const LAS bf16x8*)(lds + PG8_SA(b, h) + aoff + m * 2048 + k * 1024); } while (0)
#define PG8_LDB(dst, b, h) do { _Pragma("unroll") for (int n = 0; n < 2; ++n) _Pragma("unroll") for (int k = 0; k < 2; ++k) dst[n][k] = *(const LAS bf16x8*)(lds + PG8_SB(b, h) + boff + n * 2048 + k * 1024); } while (0)
#define PG8_MMA(ai, bj, At, Bt) do { __builtin_amdgcn_s_setprio(1); _Pragma("unroll") for (int m = 0; m < 4; ++m) _Pragma("unroll") for (int n = 0; n < 2; ++n) _Pragma("unroll") for (int k = 0; k < 2; ++k) \
        acc[ai][bj][m][n] = __builtin_amdgcn_mfma_f32_16x16x32_bf16(Bt[n][k], At[m][k], acc[ai][bj][m][n], 0, 0, 0); __builtin_amdgcn_s_setprio(0); } while (0)
#define PG8_WAIT_V(n) asm volatile("s_waitcnt vmcnt(" #n ")" ::: "memory")
#define PG8_WAIT_L(n) asm volatile("s_waitcnt lgkmcnt(" #n ")" ::: "memory")
#define PG8_BAR __builtin_amdgcn_s_barrier()
#define PG8_SCHED __builtin_amdgcn_sched_barrier(0)
    Unit cur, nxt; int ui = 0;
    if (!S.next(0, cur)) return;
    f32x4 acc[2][2][4][2];
#pragma unroll
    for (int a = 0; a < 2; ++a)
#pragma unroll
        for (int b = 0; b < 2; ++b)
#pragma unroll
            for (int m = 0; m < 4; ++m)
#pragma unroll
                for (int n = 0; n < 2; ++n) acc[a][b][m][n] = (f32x4){0.f, 0.f, 0.f, 0.f};
    bf16x8 At[4][2], B0[2][2], B1[2][2];
    const char* cA = (const char*)g.A + (size_t)cur.pm * tstepA; const char* cB = (const char*)g.Bt + (size_t)cur.pn * tstepB;
    PG8_STAGE(PG8_SB(0, 0), cB, voffB); PG8_STAGE(PG8_SA(0, 0), cA, voffA); PG8_STAGE(PG8_SB(0, 1), cB + hstepB, voffB); PG8_STAGE(PG8_SA(0, 1), cA + hstepA, voffA);
    if (wr == 1) PG8_BAR;
    PG8_WAIT_V(4); PG8_BAR;
    PG8_STAGE(PG8_SB(1, 0), cB + kstep, voffB); PG8_STAGE(PG8_SA(1, 0), cA + kstep, voffA); PG8_STAGE(PG8_SB(1, 1), cB + hstepB + kstep, voffB);
    PG8_WAIT_V(6); PG8_BAR;
    for (;;) {
        const bool has_next = S.next(ui + 1, nxt);
        const char* nA = has_next ? (const char*)g.A + (size_t)nxt.pm * tstepA : cA; const char* nB = has_next ? (const char*)g.Bt + (size_t)nxt.pn * tstepB : cB;
        for (int t = 0; t < nt; t += 2) {
            const bool last = (t == nt - 2);
            const char* a1 = cA + (size_t)(t + 1) * kstep;
            const char* a2 = last ? nA : cA + (size_t)(t + 2) * kstep; const char* b2 = last ? nB : cB + (size_t)(t + 2) * kstep;
            const char* a3 = a2 + kstep; const char* b3 = b2 + kstep;
            PG8_LDB(B0, 0, 0); PG8_SCHED; PG8_LDA(At, 0, 0); PG8_STAGE(PG8_SA(1, 1), a1 + hstepA, voffA);
            PG8_WAIT_L(8); PG8_BAR; PG8_WAIT_L(0); PG8_MMA(0, 0, At, B0); PG8_BAR; PG8_SCHED;
            PG8_LDB(B1, 0, 1); PG8_STAGE(PG8_SB(0, 0), b2, voffB);
            PG8_BAR; PG8_WAIT_L(0); PG8_MMA(0, 1, At, B1); PG8_BAR;
            PG8_LDA(At, 0, 1); PG8_STAGE(PG8_SA(0, 0), a2, voffA);
            PG8_BAR; PG8_WAIT_L(0); PG8_MMA(1, 0, At, B0); PG8_BAR; PG8_SCHED;
            PG8_STAGE(PG8_SB(0, 1), b2 + hstepB, voffB);
            PG8_WAIT_V(6); PG8_BAR; PG8_MMA(1, 1, At, B1); PG8_BAR;
            PG8_LDB(B0, 1, 0); PG8_SCHED; PG8_LDA(At, 1, 0); PG8_STAGE(PG8_SA(0, 1), a2 + hstepA, voffA);
            PG8_WAIT_L(8); PG8_BAR; PG8_WAIT_L(0); PG8_MMA(0, 0, At, B0); PG8_BAR; PG8_SCHED;
            PG8_LDB(B1, 1, 1); PG8_STAGE(PG8_SB(1, 0), b3, voffB);
            PG8_BAR; PG8_WAIT_L(0); PG8_MMA(0, 1, At, B1); PG8_BAR;
            PG8_LDA(At, 1, 1); PG8_STAGE(PG8_SA(1, 0), a3, voffA);
            PG8_BAR; PG8_WAIT_L(0); PG8_MMA(1, 0, At, B0); PG8_BAR; PG8_SCHED;
            PG8_STAGE(PG8_SB(1, 1), b3 + hstepB, voffB);
            PG8_WAIT_V(6); PG8_BAR; PG8_MMA(1, 1, At, B1); PG8_BAR;
        }
        E(acc, cur, wr, wc, fr, fq);
        if (!has_next) break;
#pragma unroll
        for (int a = 0; a < 2; ++a)
#pragma unroll
            for (int b = 0; b < 2; ++b)
#pragma unroll
                for (int m = 0; m < 4; ++m)
#pragma unroll
                    for (int n = 0; n < 2; ++n) acc[a][b][m][n] = (f32x4){0.f, 0.f, 0.f, 0.f};
        cur = nxt; cA = nA; cB = nB; ++ui;
    }
    PG8_WAIT_V(0);
    if (wr == 0) PG8_BAR;
    PG8_BAR;
#undef PG8_SA
#undef PG8_SB
#undef PG8_STAGE
#undef PG8_LDA
#undef PG8_LDB
#undef PG8_MMA
#undef PG8_WAIT_V
#undef PG8_WAIT_L
#undef PG8_BAR
#undef PG8_SCHED
}
}


struct ThinStoreRow { bf16_t* O; int ldc; __device__ __forceinline__ void operator()(int r, int c, float v) const { O[(size_t)r * ldc + c] = f2bf(v); } };
struct ThinStoreKV { unsigned char* kt; unsigned char* vt; __device__ __forceinline__ void operator()(int r, int c, float v) const { *(bf16_t*)(kv_dst(kt, vt, c >> 8, RFIRST + r, c & 248) + (c & 7) * 2) = f2bf(v); } };
template <class St>
__device__ __forceinline__ void thin_gemm16(LAS unsigned char* lds, const bf16_t* A, int lda, const bf16_t* Bt, int ldb, int K, int N, const St& store, int bx, int G) {
    const int tid = opaque(threadIdx.x), wave = __builtin_amdgcn_readfirstlane(tid >> 6), lane = tid & 63, n16 = lane & 15, g = lane >> 4;
    LAS f32x4* red = (LAS f32x4*)lds;
    const int nsteps = K / 32;
    for (int nt = bx; nt < N / 16; nt += G) {
        const bf16_t* ap = A + (size_t)n16 * lda + 8 * g; const bf16_t* bp = Bt + (size_t)(nt * 16 + n16) * ldb + 8 * g;
        f32x4 acc = (f32x4){0.f, 0.f, 0.f, 0.f};
        int ks = wave;
        for (; ks + 24 < nsteps; ks += 32) {
            bf16x8 a0 = *(const bf16x8*)(ap + (size_t)ks * 32), b0 = *(const bf16x8*)(bp + (size_t)ks * 32);
            bf16x8 a1 = *(const bf16x8*)(ap + (size_t)(ks + 8) * 32), b1 = *(const bf16x8*)(bp + (size_t)(ks + 8) * 32);
            bf16x8 a2 = *(const bf16x8*)(ap + (size_t)(ks + 16) * 32), b2 = *(const bf16x8*)(bp + (size_t)(ks + 16) * 32);
            bf16x8 a3 = *(const bf16x8*)(ap + (size_t)(ks + 24) * 32), b3 = *(const bf16x8*)(bp + (size_t)(ks + 24) * 32);
            acc = __builtin_amdgcn_mfma_f32_16x16x32_bf16(a0, b0, acc, 0, 0, 0); acc = __builtin_amdgcn_mfma_f32_16x16x32_bf16(a1, b1, acc, 0, 0, 0);
            acc = __builtin_amdgcn_mfma_f32_16x16x32_bf16(a2, b2, acc, 0, 0, 0); acc = __builtin_amdgcn_mfma_f32_16x16x32_bf16(a3, b3, acc, 0, 0, 0);
        }
        for (; ks < nsteps; ks += 8) { const bf16x8 a0 = *(const bf16x8*)(ap + (size_t)ks * 32), b0 = *(const bf16x8*)(bp + (size_t)ks * 32);
            acc = __builtin_amdgcn_mfma_f32_16x16x32_bf16(a0, b0, acc, 0, 0, 0); }
        red[wave * 64 + lane] = acc;
        __syncthreads();
        if (wave == 0) { f32x4 t = red[lane];
#pragma unroll
            for (int w = 1; w < 8; ++w) t += red[w * 64 + lane];
#pragma unroll
            for (int i = 0; i < 4; ++i) store(4 * g + i, nt * 16 + n16, t[i]); }
        __syncthreads();
    }
}

template <int MAP> __device__ __forceinline__ int map_col(int n) {
    if (MAP == 0) return n;
    if (MAP == 1) return n < 6144 ? n : (n < 8256 ? n + 8 : (n < 8264 ? n - 2112 : -1));
    const int T = n >> 8, w = n & 255; return w < 128 ? 128 * T + w : DFF + 128 * T + (w - 128);
}
template <int MAP> __device__ __forceinline__ void cvt_matrix(const float* W, int K, int Nsrc, bf16_t* WT, int Ndst, LAS float* scr, int lane, int gw, int NGW) {
    const int nblk = Ndst / 32, nitems = (K / 64) * nblk;
    for (int item = gw; item < nitems; item += NGW) {
        const int kb = item / nblk, nb = item % nblk, k0 = 64 * kb, n0 = 32 * nb;
        const int src = map_col<MAP>(n0 + (lane & 31));
        const float* wp = W + (size_t)(k0 + (lane >> 5)) * Nsrc + (src >= 0 ? src : 0);
#pragma unroll 8
        for (int i = 0; i < 32; ++i) { const int kk = 2 * i + (lane >> 5); float v = wp[(size_t)(2 * i) * Nsrc]; if (src < 0) v = 0.f; scr[kk * 33 + (lane & 31)] = v; }
        LDS_WAIT();
        const int c = lane & 7;
#pragma unroll
        for (int j = 0; j < 4; ++j) { const int n = (lane >> 3) + 8 * j; const LAS float* s = scr + (8 * c) * 33 + n;
            u32x4 o; o.x = cvt_pk_bf16(s[0 * 33], s[1 * 33]); o.y = cvt_pk_bf16(s[2 * 33], s[3 * 33]); o.z = cvt_pk_bf16(s[4 * 33], s[5 * 33]); o.w = cvt_pk_bf16(s[6 * 33], s[7 * 33]);
            *(u32x4*)(WT + (size_t)(n0 + n) * K + k0 + 8 * c) = o; }
        LDS_WAIT();
    }
}

struct Ptrs {
    const float* in[17]; float* out; unsigned char* ws;
};
__device__ __forceinline__ bf16_t* w_ptr(unsigned char* ws, int l, int which) {
    size_t off = WS_W + (size_t)l * SZ_WL;
    if (which > 0) off += SZ_WIN; if (which > 1) off += SZ_WUQ; if (which > 2) off += SZ_WUKV; if (which > 3) off += SZ_WOUT; if (which > 4) off += SZ_WGU;
    return (bf16_t*)(ws + off);
}

__device__ __forceinline__ void p_prologue(const Ptrs& P, LAS unsigned char* lds, int gw, int NGW, int wave, int lane) {
    lane = opaque(lane); gw = opaque(gw);
    LAS float* scr = (LAS float*)(lds + wave * 8704);
    for (int l = 0; l < 2; ++l) {
        cvt_matrix<1>(P.in[3] + (size_t)l * DM * NIN_SRC, DM, NIN_SRC, w_ptr(P.ws, l, 0), NIN, scr, lane, gw, NGW);
        cvt_matrix<0>(P.in[8] + (size_t)l * QL * NQF, QL, NQF, w_ptr(P.ws, l, 1), NQF, scr, lane, gw, NGW);
        cvt_matrix<0>(P.in[10] + (size_t)l * KVL * NKVF, KVL, NKVF, w_ptr(P.ws, l, 2), NKVF, scr, lane, gw, NGW);
        cvt_matrix<0>(P.in[11] + (size_t)l * DM * DM, DM, DM, w_ptr(P.ws, l, 3), DM, scr, lane, gw, NGW);
        cvt_matrix<2>(P.in[14] + (size_t)l * DM * NGU, DM, NGU, w_ptr(P.ws, l, 4), NGU, scr, lane, gw, NGW);
        cvt_matrix<0>(P.in[15] + (size_t)l * DFF * DM, DFF, DM, w_ptr(P.ws, l, 5), DM, scr, lane, gw, NGW);
    }
    float* cosT = (float*)(P.ws + WS_COS); float* sinT = (float*)(P.ws + WS_SIN);
    for (int idx = gw * 64 + lane; idx < R * 32; idx += NGW * 64) {
        const int r = idx >> 5, i = idx & 31; const int pos = r >= RFIRST ? r - RFIRST : 0;
        const float invf = (float)pow(10000.0, -(double)i / 32.0);
        const float ang = (float)pos * invf;
        cosT[idx] = (float)cos((double)ang); sinT[idx] = (float)sin((double)ang);
    }
    bf16_t* hres = (bf16_t*)(P.ws + WS_HRES); bf16_t* u = (bf16_t*)(P.ws + WS_U);
    const float* g0 = P.in[2];
    for (int r = gw; r < R; r += NGW) {
        u32x2* hr = (u32x2*)(hres + (size_t)r * DM); u32x2* ur = (u32x2*)(u + (size_t)r * DM);
        if (r < RFIRST) {
#pragma unroll
            for (int j = 0; j < 16; ++j) { hr[64 * j + lane] = (u32x2){0u, 0u}; ur[64 * j + lane] = (u32x2){0u, 0u}; }
            continue;
        }
        const f32x4* src = (const f32x4*)(r < 256 ? P.in[1] + (size_t)(r - RFIRST) * DM : P.in[0] + (size_t)(r - 256) * DM);
        f32x4 v[16]; float ss = 0.f;
#pragma unroll
        for (int j = 0; j < 16; ++j) { v[j] = src[64 * j + lane]; ss += (v[j][0] * v[j][0] + v[j][1] * v[j][1]) + (v[j][2] * v[j][2] + v[j][3] * v[j][3]); }
        const float rs = 1.0f / sqrtf(wave_sum(ss) * (1.0f / DM) + EPS);
#pragma unroll
        for (int j = 0; j < 16; ++j) { hr[64 * j + lane] = (u32x2){cvt_pk_bf16(v[j][0], v[j][1]), cvt_pk_bf16(v[j][2], v[j][3])}; const f32x4 g = ((const f32x4*)g0)[64 * j + lane];
            ur[64 * j + lane] = (u32x2){cvt_pk_bf16(v[j][0] * rs * g[0], v[j][1] * rs * g[1]), cvt_pk_bf16(v[j][2] * rs * g[2], v[j][3] * rs * g[3])}; }
    }
}

__device__ __forceinline__ void unpack8(const u32x4 w, float (&f)[8]) {
    f[0] = bflo(w.x); f[1] = bfhi(w.x); f[2] = bflo(w.y); f[3] = bfhi(w.y); f[4] = bflo(w.z); f[5] = bfhi(w.z); f[6] = bflo(w.w); f[7] = bfhi(w.w);
}
__device__ __forceinline__ u32x4 pack8f(const float (&f)[8]) { return (u32x4){cvt_pk_bf16(f[0], f[1]), cvt_pk_bf16(f[2], f[3]), cvt_pk_bf16(f[4], f[5]), cvt_pk_bf16(f[6], f[7])}; }

__device__ __forceinline__ void p_resnorm(const bf16_t* y, bf16_t* hres, bf16_t* hres_o, const float* gpost, const float* gnext, bf16_t* u, float* out, int gw, int NGW, int lane) {
    lane = opaque(lane); gw = opaque(gw);
    for (int r = gw; r < R; r += NGW) {
        if (r < RFIRST) continue;
        const u32x4* hr = (const u32x4*)(hres + (size_t)r * DM); const u32x4* yr = (const u32x4*)(y + (size_t)r * DM);
        float v[8][8]; u32x4 xw[8]; float ss = 0.f;
#pragma unroll
        for (int j = 0; j < 8; ++j) { unpack8(yr[64 * j + lane], v[j]); xw[j] = hr[64 * j + lane];
#pragma unroll
            for (int e = 0; e < 8; ++e) ss += v[j][e] * v[j][e]; }
        const float rs = 1.0f / sqrtf(wave_sum(ss) * (1.0f / DM) + EPS);
        float ss2 = 0.f;
#pragma unroll
        for (int j = 0; j < 8; ++j) { const f32x4 g0 = ((const f32x4*)gpost)[2 * (64 * j + lane)], g1 = ((const f32x4*)gpost)[2 * (64 * j + lane) + 1]; float x[8]; unpack8(xw[j], x);
            const float gg[8] = {g0[0], g0[1], g0[2], g0[3], g1[0], g1[1], g1[2], g1[3]};
#pragma unroll
            for (int e = 0; e < 8; ++e) { v[j][e] = x[e] + v[j][e] * rs * gg[e]; ss2 += v[j][e] * v[j][e]; } }
        if (out) {
            if (r >= 256) { f32x4* orow = (f32x4*)(out + (size_t)(r - 256) * DM);
#pragma unroll
                for (int j = 0; j < 8; ++j) { orow[2 * (64 * j + lane)] = (f32x4){v[j][0], v[j][1], v[j][2], v[j][3]}; orow[2 * (64 * j + lane) + 1] = (f32x4){v[j][4], v[j][5], v[j][6], v[j][7]}; } }
        } else {
            const float rs2 = 1.0f / sqrtf(wave_sum(ss2) * (1.0f / DM) + EPS);
            u32x4* ur = (u32x4*)(u + (size_t)r * DM); u32x4* ho = (u32x4*)(hres_o + (size_t)r * DM);
#pragma unroll
            for (int j = 0; j < 8; ++j) { ho[64 * j + lane] = pack8f(v[j]);
                const f32x4 g0 = ((const f32x4*)gnext)[2 * (64 * j + lane)], g1 = ((const f32x4*)gnext)[2 * (64 * j + lane) + 1];
                const float o[8] = {v[j][0] * rs2 * g0[0], v[j][1] * rs2 * g0[1], v[j][2] * rs2 * g0[2], v[j][3] * rs2 * g0[3], v[j][4] * rs2 * g1[0], v[j][5] * rs2 * g1[1], v[j][6] * rs2 * g1[2], v[j][7] * rs2 * g1[3]};
                ur[64 * j + lane] = pack8f(o); }
        }
    }
}

__device__ __forceinline__ void p_prep(const bf16_t* z, const float* convw, const float* bg, const float* gcq, const float* gckv, const float* cosT, const float* sinT,
                                       bf16_t* qc, bf16_t* kc, float* li, float* lf, bf16_t* cqn, bf16_t* ckvn, unsigned char* ktp, LAS unsigned char* lds_scr, int gw, int NGW, int lane) {
    lane = opaque(lane); gw = opaque(gw);
    for (int r = gw; r < R; r += NGW) {
        const bf16_t* zr = z + (size_t)r * NIN;
        if (r < RFIRST) {
            const unsigned zz = (unsigned)opaque(0); const u32x4 zero4 = (u32x4){zz, zz, zz, zz};
#pragma unroll
            for (int j = 0; j < 2; ++j) { *(u32x4*)(qc + (size_t)r * 1024 + 8 * (64 * j + lane)) = zero4; *(u32x4*)(kc + (size_t)r * 1024 + 8 * (64 * j + lane)) = zero4; }
#pragma unroll
            for (int j = 0; j < 3; ++j) *(u32x4*)(cqn + (size_t)r * QL + 8 * (64 * j + lane)) = zero4;
            *(u32x4*)(ckvn + (size_t)r * KVL + 8 * lane) = zero4;
            if (lane < 4) { li[(size_t)r * 4 + lane] = -__builtin_inff(); lf[(size_t)r * 4 + lane] = 0.f; }
            continue;
        }
#pragma unroll
        for (int j = 0; j < 4; ++j) {
            const int c0 = 8 * (64 * j + lane);
            float a[8];
#pragma unroll
            for (int e = 0; e < 8; ++e) a[e] = 0.f;
#pragma unroll
            for (int tap = 0; tap < 4; ++tap) {
                const u32x4 xw = *(const u32x4*)(zr + (ptrdiff_t)(tap - 3) * NIN + c0); float x[8]; unpack8(xw, x);
                const f32x4 w0 = *(const f32x4*)(convw + tap * 2048 + c0), w1 = *(const f32x4*)(convw + tap * 2048 + c0 + 4);
                a[0] += w0[0] * x[0]; a[1] += w0[1] * x[1]; a[2] += w0[2] * x[2]; a[3] += w0[3] * x[3];
                a[4] += w1[0] * x[4]; a[5] += w1[1] * x[5]; a[6] += w1[2] * x[6]; a[7] += w1[3] * x[7];
            }
            const float sc = (c0 < 1024) ? 0.0625f : 1.0f;
#pragma unroll
            for (int e = 0; e < 8; ++e) a[e] = a[e] / (1.0f + __expf(-a[e])) * sc;
            bf16_t* dst = (c0 < 1024) ? qc + (size_t)r * 1024 + c0 : kc + (size_t)r * 1024 + (c0 - 1024);
            *(u32x4*)dst = pack8f(a);
        }
        if (lane < 8) { const float val = bf2f(zr[ZGI + lane]) + bg[lane];
            if (lane < 4) li[(size_t)r * 4 + lane] = val;
            else lf[(size_t)r * 4 + (lane - 4)] = fminf(val, 0.f) - log1pf(__expf(-fabsf(val))); }
        { float x[3][8]; float ss = 0.f;
#pragma unroll
          for (int j = 0; j < 3; ++j) { unpack8(*(const u32x4*)(zr + ZCQ + 8 * (64 * j + lane)), x[j]);
#pragma unroll
              for (int e = 0; e < 8; ++e) ss += x[j][e] * x[j][e]; }
          const float rs = 1.0f / sqrtf(wave_sum(ss) * (1.0f / QL) + EPS);
#pragma unroll
          for (int j = 0; j < 3; ++j) { const int c0 = 8 * (64 * j + lane); const f32x4 g0 = *(const f32x4*)(gcq + c0), g1 = *(const f32x4*)(gcq + c0 + 4);
              float o[8] = {x[j][0] * rs * g0[0], x[j][1] * rs * g0[1], x[j][2] * rs * g0[2], x[j][3] * rs * g0[3], x[j][4] * rs * g1[0], x[j][5] * rs * g1[1], x[j][6] * rs * g1[2], x[j][7] * rs * g1[3]};
              *(u32x4*)(cqn + (size_t)r * QL + c0) = pack8f(o); } }
        { float x[8]; unpack8(*(const u32x4*)(zr + ZCKV + 8 * lane), x); float ss = 0.f;
#pragma unroll
          for (int e = 0; e < 8; ++e) ss += x[e] * x[e];
          const float rs = 1.0f / sqrtf(wave_sum(ss) * (1.0f / KVL) + EPS);
          const f32x4 g0 = *(const f32x4*)(gckv + 8 * lane), g1 = *(const f32x4*)(gckv + 8 * lane + 4);
          float o[8] = {x[0] * rs * g0[0], x[1] * rs * g0[1], x[2] * rs * g0[2], x[3] * rs * g0[3], x[4] * rs * g1[0], x[5] * rs * g1[1], x[6] * rs * g1[2], x[7] * rs * g1[3]};
          *(u32x4*)(ckvn + (size_t)r * KVL + 8 * lane) = pack8f(o); }
        { LAS unsigned short* ks = (LAS unsigned short*)(lds_scr);
          if (lane < 32) { const float x1 = bf2f(zr[ZKR + lane]), x2 = bf2f(zr[ZKR + 32 + lane]); const float c = cosT[(size_t)r * 32 + lane], s = sinT[(size_t)r * 32 + lane];
              ks[lane] = f2bf(x1 * c - x2 * s); ks[32 + lane] = f2bf(x1 * s + x2 * c); }
          LDS_WAIT();
          const u32x4 kv8 = *(const LAS u32x4*)(lds_scr + (lane & 7) * 16);
          const int tile = r >> 6, rl = r & 63;
#pragma unroll
          for (int hh = 0; hh < 2; ++hh) { const int head = (lane >> 3) + 8 * hh;
              *(u32x4*)(ktp + ((size_t)head * NTILE + tile) * KT_BYTES + kt_off(rl, 16 + (lane & 7))) = kv8; }
          LDS_WAIT(); }
    }
}

__device__ __forceinline__ void p_hcat(const float* hm, const bf16_t* z, const float* gmn, bf16_t* hcat, int gw, int NGW, int lane) {
    lane = opaque(lane); gw = opaque(gw);
    for (int r = gw; r < R; r += NGW) {
        if (r < RFIRST) {
            const unsigned zz = (unsigned)opaque(0); const u32x4 zero4 = (u32x4){zz, zz, zz, zz};
#pragma unroll
            for (int j = 0; j < 8; ++j) *(u32x4*)(hcat + (size_t)r * DM + 8 * (64 * j + lane)) = zero4;
            continue;
        }
#pragma unroll
        for (int h = 0; h < 4; ++h) {
            const int c0 = h * 512 + 8 * lane;
            const f32x4 a = *(const f32x4*)(hm + (size_t)r * 2048 + c0), b = *(const f32x4*)(hm + (size_t)r * 2048 + c0 + 4);
            const float ss = (a[0] * a[0] + a[1] * a[1]) + (a[2] * a[2] + a[3] * a[3]) + (b[0] * b[0] + b[1] * b[1]) + (b[2] * b[2] + b[3] * b[3]);
            const float rs = 1.0f / sqrtf(wave_sum(ss) * (1.0f / 512.0f) + EPS);
            float o[8]; unpack8(*(const u32x4*)(z + (size_t)r * NIN + ZO + c0), o);
            const f32x4 g0 = *(const f32x4*)(gmn + c0), g1 = *(const f32x4*)(gmn + c0 + 4);
            const float hv[8] = {a[0], a[1], a[2], a[3], b[0], b[1], b[2], b[3]}; const float gv[8] = {g0[0], g0[1], g0[2], g0[3], g1[0], g1[1], g1[2], g1[3]};
            float res[8];
#pragma unroll
            for (int e = 0; e < 8; ++e) res[e] = hv[e] * rs * gv[e] / (1.0f + __expf(-o[e]));
            *(u32x4*)(hcat + (size_t)r * DM + c0) = pack8f(res);
        }
    }
}

namespace att {
constexpr float SCALE = 0.07216878364870323f;
constexpr float THR = 8.f;
constexpr int KVBLK = 64, SHM_V = 64 * 128 * 2, SHM_K = 64 * 192 * 2;
constexpr int OFF_V = 0, OFF_K = 2 * SHM_V, OFF_WS = OFF_K + 2 * SHM_K;
__device__ __forceinline__ int v_st(int k, int c) { const int kk = (k & ~0xC) | ((k & 4) << 1) | ((k & 8) >> 1); return ((kk >> 3) * 4 + (c >> 5)) * 512 + ((kk & 7) * 32 + (c & 31)) * 2; }
__device__ __forceinline__ int v_rd_base(int lane) { return ((lane & 3) << 3) | (((lane >> 2) & 3) << 6) | (((lane >> 4) & 1) << 5) | (((lane >> 5) & 1) << 8); }
constexpr int v_rd_off(int d0, int ks, int half) { return d0 * 512 + ks * 4096 + half * 2048; }
__device__ __forceinline__ int crow(int r, int hi) { return (r & 3) + 8 * (r >> 2) + 4 * hi; }
__device__ __forceinline__ int k_off(int row, int ch) { return row * 384 + (((ch & ~7) | ((ch & 7) ^ ((row >> 1) & 7))) << 4); }

__device__ __forceinline__ void partialSM(f32x16& p0, f32x16& p1, float& m_reg, float& mn, float& alpha) {
    float pmax = p0[0];
#pragma unroll
    for (int r = 1; r < 16; ++r) pmax = fmaxf(pmax, p0[r]);
#pragma unroll
    for (int r = 0; r < 16; ++r) pmax = fmaxf(pmax, p1[r]);
    { auto rr = __builtin_amdgcn_permlane32_swap(__float_as_uint(pmax), __float_as_uint(pmax), false, false);
      pmax = fmaxf(__uint_as_float(rr[0]), __uint_as_float(rr[1])); }
    constexpr float C2 = 1.4426950408889634f * SCALE;
    if (__builtin_expect(__all((pmax - m_reg) * SCALE <= THR), 1)) { mn = m_reg; alpha = 1.f; }
    else { mn = fmaxf(m_reg, pmax); alpha = __builtin_amdgcn_exp2f((m_reg - mn) * C2); m_reg = mn; }
    const float mnL = -mn * C2;
#pragma unroll
    for (int r = 0; r < 16; ++r) p0[r] = fmaf(p0[r], C2, mnL);
#pragma unroll
    for (int r = 0; r < 16; ++r) p1[r] = fmaf(p1[r], C2, mnL);
#pragma unroll
    for (int r = 0; r < 16; ++r) p0[r] = __builtin_amdgcn_exp2f(p0[r]);
}
__device__ __forceinline__ void finishSM(f32x16& p0, f32x16& p1, float alpha, float& l_reg, bf16x8& pa0, bf16x8& pa1, bf16x8& pa2, bf16x8& pa3) {
#pragma unroll
    for (int r = 0; r < 16; ++r) p1[r] = __builtin_amdgcn_exp2f(p1[r]);
    float ps = 0;
#pragma unroll
    for (int r = 0; r < 16; ++r) ps += p0[r];
#pragma unroll
    for (int r = 0; r < 16; ++r) ps += p1[r];
    { auto rr = __builtin_amdgcn_permlane32_swap(__float_as_uint(ps), __float_as_uint(ps), false, false);
      ps = __uint_as_float(rr[0]) + __uint_as_float(rr[1]); }
    l_reg = l_reg * alpha + ps;
#define PK4(P, B_, OUT) do { unsigned a0 = cvt_pk_bf16(P[B_+0], P[B_+1]), a1 = cvt_pk_bf16(P[B_+2], P[B_+3]);                          \
        unsigned b0 = cvt_pk_bf16(P[B_+4], P[B_+5]), b1 = cvt_pk_bf16(P[B_+6], P[B_+7]);                                             \
        auto r0 = __builtin_amdgcn_permlane32_swap(a0, b0, false, false); auto r1 = __builtin_amdgcn_permlane32_swap(a1, b1, false, false); \
        u32x4 w = {r0[0], r1[0], r0[1], r1[1]}; OUT = *reinterpret_cast<bf16x8*>(&w); } while (0)
    PK4(p0, 0, pa0); PK4(p0, 8, pa1); PK4(p1, 0, pa2); PK4(p1, 8, pa3);
#undef PK4
}
template <int KB, bool NOLDS = false>
__device__ __forceinline__ void qkt(f32x16& p0, f32x16& p1, LAS const char* K_lds, int r32, int hi, const bf16x8* qr) {
    p0 = f32x16{}; p1 = f32x16{};
    if (NOLDS) {
#pragma unroll
        for (int d0 = 0; d0 < 12; ++d0) { p0 = __builtin_amdgcn_mfma_f32_32x32x16_bf16(qr[(d0 + 1) % 12], qr[d0], p0, 0, 0, 0); p1 = __builtin_amdgcn_mfma_f32_32x32x16_bf16(qr[(d0 + 2) % 12], qr[d0], p1, 0, 0, 0); }
        return; }
    LAS const char* kb[4];
#pragma unroll
    for (int dd = 0; dd < 4; ++dd) kb[dd] = K_lds + KB * SHM_K + k_off(r32, dd * 2 + hi);
    bf16x8 ka[3], kbb[3];
#define KRD(slot, d0) do { LAS const char* a_ = kb[(d0) & 3] + ((d0) >> 2) * 128; ka[slot] = *reinterpret_cast<LAS const bf16x8*>(a_); kbb[slot] = *reinterpret_cast<LAS const bf16x8*>(a_ + 32 * 384); } while (0)
    KRD(0, 0); KRD(1, 1);
#pragma unroll
    for (int d0 = 0; d0 < 12; ++d0) {
        if (d0 + 2 < 12) KRD((d0 + 2) % 3, d0 + 2);
        p0 = __builtin_amdgcn_mfma_f32_32x32x16_bf16(ka[d0 % 3], qr[d0], p0, 0, 0, 0);
        p1 = __builtin_amdgcn_mfma_f32_32x32x16_bf16(kbb[d0 % 3], qr[d0], p1, 0, 0, 0);
        __builtin_amdgcn_sched_group_barrier(0x100, 2, 0);
        __builtin_amdgcn_sched_group_barrier(0x008, 2, 0);
    }
#undef KRD
}
template <int VB, bool NOLDS = false>
__device__ __forceinline__ void pv_tile(f32x16* o, unsigned vb0, bf16x8 pa0, bf16x8 pa1, bf16x8 pa2, bf16x8 pa3) {
    if (NOLDS) {
#pragma unroll
        for (int d0 = 0; d0 < 4; ++d0) { o[d0] = __builtin_amdgcn_mfma_f32_32x32x16_bf16(pa0, pa1, o[d0], 0, 0, 0); o[d0] = __builtin_amdgcn_mfma_f32_32x32x16_bf16(pa1, pa2, o[d0], 0, 0, 0); o[d0] = __builtin_amdgcn_mfma_f32_32x32x16_bf16(pa2, pa3, o[d0], 0, 0, 0); o[d0] = __builtin_amdgcn_mfma_f32_32x32x16_bf16(pa3, pa0, o[d0], 0, 0, 0); }
        return; }
#define TRRD(dst, off) asm volatile("ds_read_b64_tr_b16 %0, %1 offset:%2" : "=&v"(dst) : "v"(vb0), "i"(off) : "memory")
#define PV_RD(S, d0) do { constexpr int b_ = VB * SHM_V + v_rd_off(d0, 0, 0); \
        TRRD(S##l0, b_); TRRD(S##h0, b_ + 2048); TRRD(S##l1, b_ + 4096); TRRD(S##h1, b_ + 6144); TRRD(S##l2, b_ + 8192); TRRD(S##h2, b_ + 10240); TRRD(S##l3, b_ + 12288); TRRD(S##h3, b_ + 14336); } while (0)
#define PV_MM(S, d0) do { \
        o[d0] = __builtin_amdgcn_mfma_f32_32x32x16_bf16(pa0, (bf16x8){S##l0[0], S##l0[1], S##l0[2], S##l0[3], S##h0[0], S##h0[1], S##h0[2], S##h0[3]}, o[d0], 0, 0, 0);   \
        o[d0] = __builtin_amdgcn_mfma_f32_32x32x16_bf16(pa1, (bf16x8){S##l1[0], S##l1[1], S##l1[2], S##l1[3], S##h1[0], S##h1[1], S##h1[2], S##h1[3]}, o[d0], 0, 0, 0);   \
        o[d0] = __builtin_amdgcn_mfma_f32_32x32x16_bf16(pa2, (bf16x8){S##l2[0], S##l2[1], S##l2[2], S##l2[3], S##h2[0], S##h2[1], S##h2[2], S##h2[3]}, o[d0], 0, 0, 0);   \
        o[d0] = __builtin_amdgcn_mfma_f32_32x32x16_bf16(pa3, (bf16x8){S##l3[0], S##l3[1], S##l3[2], S##l3[3], S##h3[0], S##h3[1], S##h3[2], S##h3[3]}, o[d0], 0, 0, 0); } while (0)
    s16x4 Al0, Al1, Al2, Al3, Ah0, Ah1, Ah2, Ah3, Bl0, Bl1, Bl2, Bl3, Bh0, Bh1, Bh2, Bh3;
    PV_RD(A, 0);
    PV_RD(B, 1); asm volatile("s_waitcnt lgkmcnt(8)" ::: "memory"); SBAR(); PV_MM(A, 0); SBAR();
    PV_RD(A, 2); asm volatile("s_waitcnt lgkmcnt(8)" ::: "memory"); SBAR(); PV_MM(B, 1); SBAR();
    PV_RD(B, 3); asm volatile("s_waitcnt lgkmcnt(8)" ::: "memory"); SBAR(); PV_MM(A, 2); SBAR();
    asm volatile("s_waitcnt lgkmcnt(0)" ::: "memory"); SBAR(); PV_MM(B, 3);
#undef PV_RD
#undef PV_MM
#undef TRRD
}

template <int ABL>
__device__ __forceinline__ void attn_unit(LAS char* lds, int head, int qb, const bf16_t* qf, const unsigned char* kt, const unsigned char* vt,
                                          const float* cosT, const float* sinT, bf16_t* hcat) {
    const int tid = opaque(threadIdx.x), wid = __builtin_amdgcn_readfirstlane(tid >> 6), lane = tid & 63, r32 = lane & 31, hi = lane >> 5;
    const int row_w0 = qb * 256 + wid * 32, qrow = row_w0 + r32;
    LAS char* V_lds = lds + OFF_V; LAS char* K_lds = lds + OFF_K;
    LAS float* wsf = (LAS float*)(lds + OFF_WS) + wid * 64; LAS float* li_l = wsf; LAS float* al_l = wsf + 32;
    bf16x8 qr[12];
    { const bf16_t* qp = qf + (size_t)qrow * NQF + head * 192 + hi * 8;
#pragma unroll
      for (int d0 = 0; d0 < 12; ++d0) qr[d0] = *(const bf16x8*)(qp + d0 * 16);
#pragma unroll
      for (int pp = 0; pp < 2; ++pp) {
          const int i0 = pp * 16 + hi * 8;
          const f32x4 c0 = *(const f32x4*)(cosT + (size_t)qrow * 32 + i0), c1 = *(const f32x4*)(cosT + (size_t)qrow * 32 + i0 + 4);
          const f32x4 s0 = *(const f32x4*)(sinT + (size_t)qrow * 32 + i0), s1 = *(const f32x4*)(sinT + (size_t)qrow * 32 + i0 + 4);
          const float cc[8] = {c0[0], c0[1], c0[2], c0[3], c1[0], c1[1], c1[2], c1[3]}, sn[8] = {s0[0], s0[1], s0[2], s0[3], s1[0], s1[1], s1[2], s1[3]};
          float x1[8], x2[8], y1[8], y2[8];
          unpack8(*reinterpret_cast<u32x4*>(&qr[8 + pp]), x1); unpack8(*reinterpret_cast<u32x4*>(&qr[10 + pp]), x2);
#pragma unroll
          for (int e = 0; e < 8; ++e) { y1[e] = x1[e] * cc[e] - x2[e] * sn[e]; y2[e] = x1[e] * sn[e] + x2[e] * cc[e]; }
          u32x4 w1 = pack8f(y1), w2 = pack8f(y2);
          qr[8 + pp] = *reinterpret_cast<bf16x8*>(&w1); qr[10 + pp] = *reinterpret_cast<bf16x8*>(&w2);
      } }
    const int NT = 4 * qb + 1;
    float m_reg = -1e30f, l_reg = 0; f32x16 o[4] = {};
    const unsigned vb0 = (unsigned)(uintptr_t)V_lds + (unsigned)v_rd_base(lane);
    const unsigned char* ktb = kt + ((size_t)head * NTILE + 3) * KT_BYTES + wid * 1024 + lane * 16;
    const unsigned char* vtb = vt + ((size_t)head * NTILE + 3) * VT_BYTES + wid * 1024 + lane * 16;
#define DMAT(t, bf) do { const unsigned char* ks_ = ktb + (size_t)(t) * KT_BYTES; const unsigned char* vs_ = vtb + (size_t)(t) * VT_BYTES; \
        _Pragma("unroll") for (int i = 0; i < 3; ++i) __builtin_amdgcn_global_load_lds((const unsigned*)(ks_ + i * 8192), (LAS unsigned*)(K_lds + (bf) * SHM_K + wid * 1024 + i * 8192), 16, 0, 0); \
        _Pragma("unroll") for (int i = 0; i < 2; ++i) __builtin_amdgcn_global_load_lds((const unsigned*)(vs_ + i * 8192), (LAS unsigned*)(V_lds + (bf) * SHM_V + wid * 1024 + i * 8192), 16, 0, 0); } while (0)
#define RESC(a) do { if (__any((a) < 1.f)) { if (hi == 0) al_l[r32] = (a); asm volatile("s_waitcnt lgkmcnt(0)" ::: "memory");              \
                     _Pragma("unroll") for (int d_ = 0; d_ < 4; ++d_) _Pragma("unroll") for (int r = 0; r < 16; ++r) o[d_][r] *= al_l[crow(r, hi)]; } } while (0)
#define STEP(t, BUF) do { \
        if (ABL != 1 && (t) + 1 < NT) DMAT((t) + 1, (BUF) ^ 1); \
        f32x16 p0, p1; float mn, alpha; bf16x8 pa0, pa1, pa2, pa3; \
        if (ABL != 4) qkt<BUF, ABL == 5 || ABL == 7>(p0, p1, K_lds, r32, hi, qr); else { p0 = f32x16{}; p1 = f32x16{}; asm volatile("" : "+v"(p0), "+v"(p1)); } \
        { const int kb_ = (3 + (t)) * KVBLK; \
          if (kb_ + KVBLK - 1 > row_w0 || kb_ < RFIRST) { const float NEG = -__builtin_inff(); \
            _Pragma("unroll") for (int r = 0; r < 16; ++r) { const int key0 = kb_ + crow(r, hi); \
                if (key0 > qrow || key0 < RFIRST) p0[r] = NEG; if (key0 + 32 > qrow || key0 + 32 < RFIRST) p1[r] = NEG; } } } \
        if (ABL != 2) partialSM(p0, p1, m_reg, mn, alpha); else { alpha = 1.f; asm volatile("" : "+v"(p0), "+v"(p1)); } \
        RESC(alpha); \
        if (ABL != 2) finishSM(p0, p1, alpha, l_reg, pa0, pa1, pa2, pa3); else { u32x4 w0 = {cvt_pk_bf16(p0[0], p0[1]), cvt_pk_bf16(p0[2], p0[3]), cvt_pk_bf16(p0[4], p0[5]), cvt_pk_bf16(p0[6], p0[7])}; pa0 = *reinterpret_cast<bf16x8*>(&w0); pa1 = pa0; pa2 = pa0; pa3 = pa0; l_reg += p1[0]; } SBAR(); \
        if (ABL != 3) pv_tile<BUF, ABL == 6 || ABL == 7>(o, vb0, pa0, pa1, pa2, pa3); else { asm volatile("" :: "v"(pa0), "v"(pa1), "v"(pa2), "v"(pa3)); } \
        asm volatile("s_waitcnt vmcnt(0)" ::: "memory"); \
        __syncthreads(); } while (0)
    DMAT(0, 0); asm volatile("s_waitcnt vmcnt(0)" ::: "memory"); __syncthreads();
    for (int t = 0; t < NT; t += 2) {
        STEP(t, 0);
        if (t + 1 < NT) STEP(t + 1, 1);
    }
    if (hi == 0) li_l[r32] = l_reg; asm volatile("s_waitcnt lgkmcnt(0)" ::: "memory");
    float rli[16];
#pragma unroll
    for (int r = 0; r < 16; ++r) rli[r] = __builtin_amdgcn_rcpf(li_l[crow(r, hi)]);
    bf16_t* Ow = hcat + (size_t)row_w0 * DM + 2048 + head * 128;
#pragma unroll
    for (int r = 0; r < 16; ++r) { const int orow = crow(r, hi);
#pragma unroll
        for (int d0 = 0; d0 < 4; ++d0) { const float v = o[d0][r] * rli[r]; const float vn = __shfl_xor(v, 1);
            if ((r32 & 1) == 0 && row_w0 + orow >= RFIRST) *(unsigned*)(Ow + (size_t)orow * DM + d0 * 32 + r32) = cvt_pk_bf16(v, vn); } }
#undef DMAT
#undef RESC
#undef STEP
}
}

namespace mls {
constexpr int QP = 528, VP = 272, SP = 144;
constexpr int Q_OFF = 0, K_OFF = 33792, V_OFF = 67584, S_OFF = 84992, SC_OFF = 94208, DEN_OFF = 110592, N_OFF = 110848, GC_OFF = 112896;
__device__ __forceinline__ f32x4 mfma16(bf16x8 a, bf16x8 b, f32x4 c) { return __builtin_amdgcn_mfma_f32_16x16x32_bf16(a, b, c, 0, 0, 0); }
#define TR64(dst, addr, off) asm volatile("ds_read_b64_tr_b16 %0, %1 offset:%2" : "=&v"(dst) : "v"(addr), "i"(off) : "memory")

__device__ __forceinline__ void mlstm_unit(LAS unsigned char* lds, int h, int sl, int grp, int so, const bf16_t* qc, const bf16_t* kc, const bf16_t* z, const float* li, const float* lf, float* hm, float* cst, float* nst, unsigned* p1cnt, unsigned* tmo) {
    const int tid = opaque(threadIdx.x), wave = __builtin_amdgcn_readfirstlane(tid >> 6), lane = tid & 63, n16 = lane & 15, g = lane >> 4;
    const int tq = (lane >> 2) & 3, tp = lane & 3;
    const unsigned lbase = (unsigned)(uintptr_t)lds;
    LAS float* sc_u = (LAS float*)(lds + SC_OFF + wave * 2048); LAS float* sc_vv = sc_u + 64; LAS float* sc_wi = sc_u + 128; LAS float* sc_fl = sc_u + 192; LAS float* sc_ew = sc_u + 256;
    LAS float* den_l = (LAS float*)(lds + DEN_OFF); LAS float* nbuf = (LAS float*)(lds + N_OFF);
    const int dvb = sl * 128 + wave * 16;
    f32x4 Cacc[16];
#pragma unroll
    for (int i = 0; i < 16; ++i) Cacc[i] = (f32x4){0.f, 0.f, 0.f, 0.f};
    float m_c = 0.f;
    nbuf[tid] = 0.f;
    const int u16 = h * 4 + sl;
    const int c_beg = grp == 0 ? 3 : (grp == 1 ? 67 : (grp == 2 ? 131 : 195)), c_end = grp == 0 ? 67 : (grp == 1 ? 131 : (grp == 2 ? 195 : NCHUNK));
    float coef0 = 0.f, coef1 = 0.f, coef2 = 0.f;
    if (grp > 0) {
        LAS float* gC = (LAS float*)(lds + GC_OFF); LAS float* vmC = gC + 264;
        for (int c = 3 + wave; c < c_beg; c += 8) {
            const float li_t = li[((size_t)c * 64 + lane) * 4 + h], lf_t = lf[((size_t)c * 64 + lane) * 4 + h];
            float b = lf_t;
#pragma unroll
            for (int o = 1; o < 64; o <<= 1) { const float t_ = __shfl_up(b, o); if (lane >= o) b += t_; }
            float vm = li_t - b;
#pragma unroll
            for (int o = 1; o < 64; o <<= 1) vm = fmaxf(vm, __shfl_xor(vm, o));
            if (lane == 63) { gC[c] = b; vmC[c] = vm; }
        }
        __syncthreads();
        float m = 0.f, mS1 = 0.f, mS2 = 0.f, mS3 = 0.f, G1 = 0.f, G2 = 0.f;
        for (int c = 3; c < c_beg; ++c) { const float gg = gC[c]; m = fmaxf(gg + m, gg + vmC[c]);
            if (c >= 67 && c < 131) G1 += gg; if (c >= 131 && c < 195) G2 += gg;
            if (c == 66) mS1 = m; if (c == 130) mS2 = m; if (c == 194) mS3 = m; }
        m_c = m;
        const float P1 = fexp(G1 + mS1 - mS2), P2 = fexp(G2 + mS2 - mS3);
        if (grp == 1) { coef0 = 1.f; }
        else if (grp == 2) { coef0 = P1; coef1 = 1.f; }
        else { coef0 = P2 * P1; coef1 = P2; coef2 = 1.f; }
    }
    bf16x8 sq[4], sk[4], sv[2]; float pli, plf;
    const int srow = tid >> 5, sch = tid & 31, vrow0 = tid >> 4, vch = tid & 15;
    const bf16_t* gq = qc + (size_t)srow * 1024 + h * 256 + sch * 8; const bf16_t* gk = kc + (size_t)srow * 1024 + h * 256 + sch * 8;
    const bf16_t* gv = z + (size_t)vrow0 * NIN + ZV + h * 512 + sl * 128 + vch * 8;
    LAS unsigned char* wq = lds + Q_OFF + srow * QP + sch * 16; LAS unsigned char* wv = lds + V_OFF + vrow0 * VP + vch * 16;
#define ML_LOAD(c) do { const size_t r0_ = (size_t)(c) * 64; \
        _Pragma("unroll") for (int i = 0; i < 4; ++i) { sq[i] = *(const bf16x8*)(gq + (r0_ + 16 * i) * 1024); sk[i] = *(const bf16x8*)(gk + (r0_ + 16 * i) * 1024); } \
        sv[0] = *(const bf16x8*)(gv + r0_ * NIN); sv[1] = *(const bf16x8*)(gv + (r0_ + 32) * NIN); pli = li[(r0_ + lane) * 4 + h]; plf = lf[(r0_ + lane) * 4 + h]; } while (0)
#define ML_WRITE() do { _Pragma("unroll") for (int i = 0; i < 4; ++i) { *(LAS bf16x8*)(wq + i * 16 * QP) = sq[i]; *(LAS bf16x8*)(wq + (K_OFF - Q_OFF) + i * 16 * QP) = sk[i]; } \
        *(LAS bf16x8*)(wv) = sv[0]; *(LAS bf16x8*)(wv + 32 * VP) = sv[1]; } while (0)
    LAS const unsigned char* qrow_b = lds + Q_OFF + n16 * QP + g * 16;
    LAS const unsigned char* qsub_b = lds + Q_OFF + n16 * QP + (g >> 1) * 16 + (g & 1) * 8;
    LAS const unsigned char* srow_b = lds + S_OFF + n16 * SP + g * 16;
    const unsigned ktr_b = lbase + K_OFF + (8 * g + tq) * QP + (tp >> 1) * 16 + (tp & 1) * 8;
    const unsigned vtr_b = lbase + V_OFF + (8 * g + tq) * VP + (2 * wave + (tp >> 1)) * 16 + (tp & 1) * 8;
    if (!so && grp > 0) {
        if (tid == 0) { unsigned sp = 0;
            while (__hip_atomic_load(p1cnt, __ATOMIC_RELAXED, __HIP_MEMORY_SCOPE_AGENT) < 48u) { __builtin_amdgcn_s_sleep(8);
                if ((++sp & 255u) == 0u) { if (__hip_atomic_load(tmo, __ATOMIC_RELAXED, __HIP_MEMORY_SCOPE_AGENT)) break; if (sp > (1u << 22)) { atomicAdd(tmo, 1u); break; } } }
            __builtin_amdgcn_fence(__ATOMIC_ACQUIRE, "agent");
            asm volatile("s_waitcnt vmcnt(0)" ::: "memory"); }
        __syncthreads();
        float nacc = 0.f;
#pragma unroll
        for (int gp = 0; gp < 3; ++gp) { const float cf = gp == 0 ? coef0 : (gp == 1 ? coef1 : coef2);
            if (gp < grp) { const f32x4* src = (const f32x4*)(cst + (((size_t)gp * 16 + u16) * 512 + tid) * 64);
#pragma unroll
                for (int i = 0; i < 16; ++i) Cacc[i] += cf * src[i];
                if (tid < 256) nacc += cf * nst[((size_t)gp * 16 + u16) * 256 + tid]; } }
        if (tid < 256) nbuf[(c_beg & 1) * 256 + tid] = nacc;
    }
    ML_LOAD(c_beg); ML_WRITE(); __syncthreads();
    for (int c = c_beg; c < c_end; ++c) {
        const float li_t = pli, lf_t = plf;
        if (c + 1 < c_end) ML_LOAD(c + 1);
        const size_t r0 = (size_t)c * 64;
        float b = lf_t;
#pragma unroll
        for (int o = 1; o < 64; o <<= 1) { const float t_ = __shfl_up(b, o); if (lane >= o) b += t_; }
        const float vv = li_t - b;
        float pm = vv;
#pragma unroll
        for (int o = 1; o < 64; o <<= 1) { const float t_ = __shfl_up(pm, o); if (lane >= o) pm = fmaxf(pm, t_); }
        const float gl = __shfl(b, 63), vvmax = __shfl(pm, 63);
        const float mt_ = fmaxf(b + m_c, b + pm);
        const float u_t = b - mt_;
        const float m_next = fmaxf(gl + m_c, gl + vvmax);
        const float decay = fexp(gl + m_c - m_next);
        sc_u[lane] = u_t; sc_vv[lane] = vv; sc_wi[lane] = fexp(u_t + m_c); sc_fl[lane] = fexp(-mt_); sc_ew[lane] = fexp(gl + vv - m_next);
        LDS_WAIT();
        f32x4 acc[4];
        if (!so) {
        {
            const int tT = wave >> 1, sT0 = 2 * (wave & 1);
            f32x4 s0 = (f32x4){0.f, 0.f, 0.f, 0.f}, s1 = s0;
            if (sT0 <= tT) {
                LAS const unsigned char* ab = qrow_b + tT * 16 * QP; LAS const unsigned char* bb = qrow_b + (K_OFF - Q_OFF) + sT0 * 16 * QP;
#pragma unroll
                for (int ks = 0; ks < 8; ++ks) {
                    const bf16x8 a = *(const LAS bf16x8*)(ab + ks * 64);
                    const bf16x8 b0 = *(const LAS bf16x8*)(bb + ks * 64);
                    const bf16x8 b1 = *(const LAS bf16x8*)(bb + 16 * QP + ks * 64);
                    s0 = mfma16(a, b0, s0); s1 = mfma16(a, b1, s1);
                }
            }
#pragma unroll
            for (int jj = 0; jj < 2; ++jj) {
                const int s_ = 16 * (sT0 + jj) + n16; const float vvs = sc_vv[s_];
#pragma unroll
                for (int i = 0; i < 4; ++i) { const int t_ = 16 * tT + 4 * g + i;
                    const float sv_ = (jj == 0 ? s0[i] : s1[i]);
                    const float val = (s_ <= t_) ? sv_ * fexp(sc_u[t_] + vvs) : 0.f;
                    *(LAS unsigned short*)(lds + S_OFF + t_ * SP + s_ * 2) = f2bf(val); }
            }
        }
#pragma unroll
        for (int mt = 0; mt < 4; ++mt) acc[mt] = (f32x4){0.f, 0.f, 0.f, 0.f};
#pragma unroll
        for (int i = 0; i < 8; ++i) {
            u32x4 bw; bw.x = cvt_pk_bf16(Cacc[2 * i][0], Cacc[2 * i][1]); bw.y = cvt_pk_bf16(Cacc[2 * i][2], Cacc[2 * i][3]);
            bw.z = cvt_pk_bf16(Cacc[2 * i + 1][0], Cacc[2 * i + 1][1]); bw.w = cvt_pk_bf16(Cacc[2 * i + 1][2], Cacc[2 * i + 1][3]);
            const bf16x8 bfr = *reinterpret_cast<bf16x8*>(&bw);
#pragma unroll
            for (int mt = 0; mt < 4; ++mt) {
                const u32x2 lo = *(const LAS u32x2*)(qsub_b + mt * 16 * QP + i * 64);
                const u32x2 hi2 = *(const LAS u32x2*)(qsub_b + mt * 16 * QP + i * 64 + 32);
                u32x4 aw = (u32x4){lo.x, lo.y, hi2.x, hi2.y};
                acc[mt] = mfma16(*reinterpret_cast<bf16x8*>(&aw), bfr, acc[mt]); }
        }
#pragma unroll
        for (int mt = 0; mt < 4; ++mt)
#pragma unroll
            for (int i = 0; i < 4; ++i) acc[mt][i] *= sc_wi[16 * mt + 4 * g + i];
        __syncthreads();
        }
        LAS const float* ncur = nbuf + (c & 1) * 256; LAS float* nnext = nbuf + ((c + 1) & 1) * 256;
        if (!so) {
            const int t_ = 8 * wave + (lane >> 3), seg = lane & 7;
            float sv8[8]; unpack8(*(const LAS u32x4*)(lds + S_OFF + t_ * SP + seg * 16), sv8);
            float rsum = ((sv8[0] + sv8[1]) + (sv8[2] + sv8[3])) + ((sv8[4] + sv8[5]) + (sv8[6] + sv8[7]));
            float qn = 0.f;
#pragma unroll
            for (int cc = 0; cc < 4; ++cc) { float q8[8]; unpack8(*(const LAS u32x4*)(lds + Q_OFF + t_ * QP + (4 * seg + cc) * 16), q8);
                const f32x4 n0 = *(const LAS f32x4*)(ncur + 32 * seg + 8 * cc), n1 = *(const LAS f32x4*)(ncur + 32 * seg + 8 * cc + 4);
                qn += (q8[0] * n0[0] + q8[1] * n0[1]) + (q8[2] * n0[2] + q8[3] * n0[3]) + (q8[4] * n1[0] + q8[5] * n1[1]) + (q8[6] * n1[2] + q8[7] * n1[3]); }
            rsum += __shfl_xor(rsum, 1); rsum += __shfl_xor(rsum, 2); rsum += __shfl_xor(rsum, 4);
            qn += __shfl_xor(qn, 1); qn += __shfl_xor(qn, 2); qn += __shfl_xor(qn, 4);
            if (seg == 0) den_l[t_] = 1.0f / fmaxf(fabsf(sc_wi[t_] * qn + rsum), sc_fl[t_]);
        }
        if (tid < 256) { float nn = decay * ncur[tid]; LAS const unsigned char* kp = lds + K_OFF + tid * 2;
#pragma unroll 8
            for (int s_ = 0; s_ < 64; ++s_) nn += sc_ew[s_] * bf2f(*(const LAS unsigned short*)(kp + s_ * QP));
            nnext[tid] = nn; }
        bf16x8 vB[2];
        { s16x4 l0, h0, l1, h1;
          TR64(l0, vtr_b, 0); TR64(h0, vtr_b, 4 * VP); TR64(l1, vtr_b, 32 * VP); TR64(h1, vtr_b, 36 * VP); LDS_WAIT(); SBAR();
          vB[0] = (bf16x8){l0[0], l0[1], l0[2], l0[3], h0[0], h0[1], h0[2], h0[3]}; vB[1] = (bf16x8){l1[0], l1[1], l1[2], l1[3], h1[0], h1[1], h1[2], h1[3]}; }
        if (!so) {
#pragma unroll
        for (int ks = 0; ks < 2; ++ks)
#pragma unroll
            for (int mt = 0; mt < 4; ++mt) {
                const bf16x8 a = *(const LAS bf16x8*)(srow_b + mt * 16 * SP + ks * 64);
                acc[mt] = mfma16(a, vB[ks], acc[mt]); }
        __syncthreads();
        { float* hp = hm + (r0 + 4 * g) * 2048 + h * 512 + dvb + n16;
#pragma unroll
          for (int mt = 0; mt < 4; ++mt)
#pragma unroll
            for (int i = 0; i < 4; ++i) { const int t_ = 16 * mt + 4 * g + i;
                hp[(size_t)(16 * mt + i) * 2048] = acc[mt][i] * den_l[t_]; } }
        }
        bf16x8 vBs[2];
#pragma unroll
        for (int ks = 0; ks < 2; ++ks) { float f8[8]; unpack8(*reinterpret_cast<u32x4*>(&vB[ks]), f8);
#pragma unroll
            for (int j = 0; j < 8; ++j) f8[j] *= sc_ew[32 * ks + 8 * g + j];
            u32x4 w = pack8f(f8); vBs[ks] = *reinterpret_cast<bf16x8*>(&w); }
#pragma unroll
        for (int i = 0; i < 16; ++i) Cacc[i] *= decay;
#define ML_UPD(ks, ib) do { s16x4 l0, h0, l1, h1, l2, h2, l3, h3; constexpr int o_ = (ks) * 32 * QP + (ib) * 32; \
            TR64(l0, ktr_b, o_); TR64(h0, ktr_b, o_ + 4 * QP); TR64(l1, ktr_b, o_ + 32); TR64(h1, ktr_b, o_ + 32 + 4 * QP); \
            TR64(l2, ktr_b, o_ + 64); TR64(h2, ktr_b, o_ + 64 + 4 * QP); TR64(l3, ktr_b, o_ + 96); TR64(h3, ktr_b, o_ + 96 + 4 * QP); LDS_WAIT(); SBAR(); \
            Cacc[(ib) + 0] = mfma16((bf16x8){l0[0], l0[1], l0[2], l0[3], h0[0], h0[1], h0[2], h0[3]}, vBs[ks], Cacc[(ib) + 0]); \
            Cacc[(ib) + 1] = mfma16((bf16x8){l1[0], l1[1], l1[2], l1[3], h1[0], h1[1], h1[2], h1[3]}, vBs[ks], Cacc[(ib) + 1]); \
            Cacc[(ib) + 2] = mfma16((bf16x8){l2[0], l2[1], l2[2], l2[3], h2[0], h2[1], h2[2], h2[3]}, vBs[ks], Cacc[(ib) + 2]); \
            Cacc[(ib) + 3] = mfma16((bf16x8){l3[0], l3[1], l3[2], l3[3], h3[0], h3[1], h3[2], h3[3]}, vBs[ks], Cacc[(ib) + 3]); } while (0)
        ML_UPD(0, 0); ML_UPD(0, 4); ML_UPD(0, 8); ML_UPD(0, 12); ML_UPD(1, 0); ML_UPD(1, 4); ML_UPD(1, 8); ML_UPD(1, 12);
#undef ML_UPD
        m_c = m_next;
        __syncthreads();
        if (c + 1 < c_end) ML_WRITE();
        __syncthreads();
    }
    if (so) {
        f32x4* dst = (f32x4*)(cst + (((size_t)grp * 16 + u16) * 512 + tid) * 64);
#pragma unroll
        for (int i = 0; i < 16; ++i) dst[i] = Cacc[i];
        if (tid < 256) nst[((size_t)grp * 16 + u16) * 256 + tid] = nbuf[(c_end & 1) * 256 + tid];
        asm volatile("s_waitcnt vmcnt(0)" ::: "memory");
        __syncthreads();
        if (tid == 0) { __builtin_amdgcn_fence(__ATOMIC_RELEASE, "agent"); asm volatile("s_waitcnt vmcnt(0)" ::: "memory");
            __hip_atomic_fetch_add(p1cnt, 1u, __ATOMIC_RELAXED, __HIP_MEMORY_SCOPE_AGENT); }
    }
#undef ML_LOAD
#undef ML_WRITE
}
#undef TR64
}

constexpr int LDS_BYTES = 147456;
constexpr int MISC_OFF = 131072 + 4096;
constexpr int NPHASE = 21;
struct Args { Ptrs p; int ph_lo, ph_hi; };

__global__ void __launch_bounds__(512, 2) fwd_kernel(Args args) {
    extern __shared__ __attribute__((aligned(16))) unsigned char lds_raw[];
    LAS unsigned char* lds = (LAS unsigned char*)lds_raw;
    volatile LAS unsigned* MISC = (volatile LAS unsigned*)(lds + MISC_OFF);
    const int tid = threadIdx.x, lane = tid & 63, wave = __builtin_amdgcn_readfirstlane(tid >> 6);
    const int G = gridDim.x; const int bx = blockIdx.x;
    const int gw = bx * 8 + wave, NGW = G * 8;
    const Ptrs& P = args.p;
    unsigned char* ws = P.ws;
    unsigned* ctl = (unsigned*)(ws + WS_CTL);
    if (tid < 64) MISC[tid] = 0u;
    __syncthreads();
#if MK_PER_PHASE
    XcdBarrier bar; bar.bar = ctl + CW_BAR; bar.x = 0; bar.st = nullptr;
#define GRID_BAR() do { } while (0)
#else
    XcdBarrier bar = xcd_barrier_post(ctl + CW_BAR, MISC + 8);
#define GRID_BAR() xcd_barrier(bar)
#endif
    const int lo = args.ph_lo, hi = args.ph_hi;
#ifndef PH_MASK
#define PH_MASK 0xFFFF
#endif
#define PHON(t) (((PH_MASK) >> (t)) & 1)
#ifndef DUP_MASK
#define DUP_MASK 0
#endif
#ifndef ABL_ATT
#define ABL_ATT 0
#endif
#define NREP(t) ((((DUP_MASK) >> (t)) & 1) ? 2 : 1)
#define IN(k) (lo <= (k) && (k) < hi)
#define BOTH(k) (IN(k) && IN((k) + 1))

    bf16_t* hres = (bf16_t*)(ws + WS_HRES); bf16_t* u = (bf16_t*)(ws + WS_U); bf16_t* z = (bf16_t*)(ws + WS_Z);
    bf16_t* qc = (bf16_t*)(ws + WS_QC); bf16_t* kc = (bf16_t*)(ws + WS_KC); bf16_t* cqn = (bf16_t*)(ws + WS_CQN); bf16_t* ckvn = (bf16_t*)(ws + WS_CKVN);
    bf16_t* krr = (bf16_t*)(ws + WS_KRR); bf16_t* qf = (bf16_t*)(ws + WS_QF); bf16_t* kvf = (bf16_t*)(ws + WS_KVF); float* hm = (float*)(ws + WS_HM);
    bf16_t* hcat = (bf16_t*)(ws + WS_HCAT); bf16_t* mix = z; bf16_t* act = z; bf16_t* yb = kvf;
    float* cosT = (float*)(ws + WS_COS); float* sinT = (float*)(ws + WS_SIN); float* li = (float*)(ws + WS_LI); float* lf = (float*)(ws + WS_LF);

    if (PHON(0) && IN(0)) { for (int rep = 0; rep < NREP(0); ++rep) { p_prologue(P, lds, gw, NGW, wave, lane); if (BOTH(0)) GRID_BAR(); } }

#pragma unroll 1
    for (int l = 0; l < 2; ++l) {
        const int pb = 1 + 10 * l;
        if (PHON(1) && IN(pb + 0)) { for (int rep = 0; rep < NREP(1); ++rep) {
            pg8::Gemm g{u, w_ptr(ws, l, 0), R, NIN, DM, DM, DM}; pg8::StaticOrder S; S.init(R, NIN, G, bx);
            pg8::EpiBf16 E{z, NIN};
            pg8::gemm_phase<pg8::EpiBf16>(lds, g, S, E);
            if (BOTH(pb + 0)) GRID_BAR();
        } }
        if (PHON(2) && IN(pb + 1)) { for (int rep = 0; rep < NREP(2); ++rep) {
            p_prep(z, P.in[4] + (size_t)l * 4 * 2048, P.in[5] + l * 8, P.in[7] + (size_t)l * QL, P.in[9] + (size_t)l * KVL, cosT, sinT, qc, kc, li, lf, cqn, ckvn, ws + WS_KT, lds + wave * 128, gw, NGW, lane);
            if (BOTH(pb + 1)) GRID_BAR();
        } }
        if (PHON(3) && IN(pb + 2)) { for (int rep = 0; rep < NREP(3); ++rep) {
            {
                pg8::Gemm g{cqn + (size_t)256 * QL, w_ptr(ws, l, 1), SEQ, NQF, QL, QL, QL}; pg8::StaticOrder S; S.init(SEQ, NQF, G, bx);
                pg8::EpiBf16 E{qf + (size_t)256 * NQF, NQF}; pg8::gemm_phase<pg8::EpiBf16>(lds, g, S, E);
                __syncthreads();
                thin_gemm16(lds, cqn + (size_t)RFIRST * QL, QL, w_ptr(ws, l, 1), QL, QL, NQF, ThinStoreRow{qf + (size_t)RFIRST * NQF, NQF}, bx, G);
                __syncthreads();
            }
            {
                pg8::Gemm g{ckvn + (size_t)256 * KVL, w_ptr(ws, l, 2), SEQ, NKVF, KVL, KVL, KVL}; pg8::StaticOrder S; S.init(SEQ, NKVF, G, bx);
                pg8::EpiKV E{ws + WS_KT, ws + WS_VT, 256}; pg8::gemm_phase<pg8::EpiKV>(lds, g, S, E);
                __syncthreads();
                thin_gemm16(lds, ckvn + (size_t)RFIRST * KVL, KVL, w_ptr(ws, l, 2), KVL, KVL, NKVF, ThinStoreKV{ws + WS_KT, ws + WS_VT}, bx, G);
                __syncthreads();
            }
            if (BOTH(pb + 2)) GRID_BAR();
        } }
        if (PHON(4) && IN(pb + 3)) { for (int rep = 0; rep < NREP(4); ++rep) {
            unsigned* qhead = ctl + CW_Q + 64 * l + 1024 * rep;
            constexpr int NUNITS = 48 + 64 + NQB * 16;
            unsigned* p1cnt = ctl + CW_P1 + 64 * l + 1024 * rep; float* cst = (float*)(ws + WS_CST); float* nst = (float*)(ws + WS_NST);
            unsigned* qatt = ctl + CW_QA + (l * 8) * 64 + 8192 * rep;
            const int myx = (int)(xb_xcc_id() & 7u);
            int ml_done = 0, tries = 0;
            for (;;) {
                __syncthreads();
                if (tid == 0) {
                    int got = -1;
                    if (!ml_done) { const unsigned v_ = __hip_atomic_fetch_add(qhead, 1u, __ATOMIC_RELAXED, __HIP_MEMORY_SCOPE_AGENT); if (v_ < 112u) got = (int)v_; else ml_done = 1; }
                    while (got < 0 && tries < 8) { const int x_ = (myx + tries) & 7;
                        const unsigned j_ = __hip_atomic_fetch_add(qatt + x_ * 64, 1u, __ATOMIC_RELAXED, __HIP_MEMORY_SCOPE_AGENT);
                        if (j_ < 130u) got = 112 + x_ * 130 + (int)j_; else ++tries; }
                    MISC[0] = (unsigned)got;
                }
                __syncthreads();
                const int un = (int)MISC[0];
                if (un < 0) break;
                if (un < 112) { if (!PHON(16) && !(rep == 1 && PHON(18)) && !(ABL_ATT != 0 && NREP(4) == 2 && rep == 0)) { const int so = un < 48, v_ = so ? un : un - 48;
                    mls::mlstm_unit(lds, (v_ & 15) >> 2, v_ & 3, v_ >> 4, so, qc, kc, z, li, lf, hm, cst, nst, p1cnt, ctl + CW_BAR + XB_TMO); } }
                else if (!PHON(17) && !(rep == 1 && PHON(19))) { const int v_ = un - 112, x_ = v_ / 130, j_ = v_ - x_ * 130; const int head = 2 * x_ + (j_ & 1), qb = (NQB - 1) - (j_ >> 1);
                    if (ABL_ATT != 0 && NREP(4) == 2 && rep == 0) att::attn_unit<ABL_ATT>((LAS char*)lds, head, qb, qf, ws + WS_KT, ws + WS_VT, cosT, sinT, hcat); else
                    att::attn_unit<0>((LAS char*)lds, head, qb, qf, ws + WS_KT, ws + WS_VT, cosT, sinT, hcat); }
            }
            if (BOTH(pb + 3)) GRID_BAR();
        } }
        if (PHON(5) && IN(pb + 4)) { for (int rep = 0; rep < NREP(5); ++rep) {
            p_hcat(hm, z, P.in[6] + (size_t)l * 2048, hcat, gw, NGW, lane);
            if (BOTH(pb + 4)) GRID_BAR();
        } }
        if (PHON(6) && IN(pb + 5)) { for (int rep = 0; rep < NREP(6); ++rep) {
            pg8::Gemm g{hcat + (size_t)256 * DM, w_ptr(ws, l, 3), SEQ, DM, DM, DM, DM}; pg8::StaticOrder S; S.init(SEQ, DM, G, bx);
            pg8::EpiBf16 E{mix + (size_t)256 * DM, DM}; pg8::gemm_phase<pg8::EpiBf16>(lds, g, S, E);
            __syncthreads();
            thin_gemm16(lds, hcat + (size_t)RFIRST * DM, DM, w_ptr(ws, l, 3), DM, DM, DM, ThinStoreRow{mix + (size_t)RFIRST * DM, DM}, bx, G);
            if (BOTH(pb + 5)) GRID_BAR();
        } }
        if (PHON(7) && IN(pb + 6)) { for (int rep = 0; rep < NREP(7); ++rep) {
            p_resnorm(mix, hres, rep ? (bf16_t*)(ws + WS_END) : hres, P.in[12] + (size_t)l * DM, P.in[13] + (size_t)l * DM, rep ? (bf16_t*)(ws + WS_END + (size_t)R * DM * 4) : u, nullptr, gw, NGW, lane);
            if (BOTH(pb + 6)) GRID_BAR();
        } }
        if (PHON(8) && IN(pb + 7)) { for (int rep = 0; rep < NREP(8); ++rep) {
            pg8::Gemm g{u, w_ptr(ws, l, 4), R, NGU, DM, DM, DM}; pg8::StaticOrder S; S.init(R, NGU, G, bx);
            pg8::EpiSwiGLU E{act, DFF}; pg8::gemm_phase<pg8::EpiSwiGLU>(lds, g, S, E);
            if (BOTH(pb + 7)) GRID_BAR();
        } }
        if (PHON(9) && IN(pb + 8)) { for (int rep = 0; rep < NREP(9); ++rep) {
            pg8::Gemm g{act + (size_t)256 * DFF, w_ptr(ws, l, 5), SEQ, DM, DFF, DFF, DFF}; pg8::StaticOrder S; S.init(SEQ, DM, G, bx);
            pg8::EpiBf16 E{yb + (size_t)256 * DM, DM}; pg8::gemm_phase<pg8::EpiBf16>(lds, g, S, E);
            __syncthreads();
            thin_gemm16(lds, act + (size_t)RFIRST * DFF, DFF, w_ptr(ws, l, 5), DFF, DFF, DM, ThinStoreRow{yb + (size_t)RFIRST * DM, DM}, bx, G);
            if (BOTH(pb + 8)) GRID_BAR();
        } }
        if (PHON(10) && IN(pb + 9)) {
            if (l == 0) p_resnorm(yb, hres, hres, P.in[16], P.in[2] + DM, u, nullptr, gw, NGW, lane);
            else p_resnorm(yb, hres, hres, P.in[16] + DM, nullptr, nullptr, P.out, gw, NGW, lane);
            if (BOTH(pb + 9)) GRID_BAR();
        }
    }
#undef IN
#undef BOTH
}

extern "C" void kernel_launch(void* const* d_in, const int* in_sizes, int n_in, void* d_out, int out_size, void* d_ws, size_t ws_size, hipStream_t stream) {
    static int grid = 0;
    if (grid == 0) {
        if (n_in != 17 || out_size != SEQ * DM || ws_size < WS_END) { fprintf(stderr, "kernel_launch: unexpected shapes (n_in %d, out %d, ws %zu < %zu)\n", n_in, out_size, ws_size, (size_t)WS_END); grid = -1; return; }
        int dev = 0, cus = 0, per_cu = 0;
        if (hipGetDevice(&dev) != hipSuccess || hipDeviceGetAttribute(&cus, hipDeviceAttributeMultiprocessorCount, dev) != hipSuccess) { grid = -1; return; }
        if (hipFuncSetAttribute((const void*)fwd_kernel, hipFuncAttributeMaxDynamicSharedMemorySize, LDS_BYTES) != hipSuccess) { fprintf(stderr, "kernel_launch: hipFuncSetAttribute failed\n"); grid = -1; return; }
        if (hipOccupancyMaxActiveBlocksPerMultiprocessor(&per_cu, (const void*)fwd_kernel, 512, LDS_BYTES) != hipSuccess || per_cu < 1) fprintf(stderr, "kernel_launch: occupancy query reports %d\n", per_cu);
        (void)hipGetLastError();
        grid = cus;
    }
    if (grid < 0) return;
    (void)hipMemsetAsync((char*)d_ws + WS_CTL, 0, CTL_BYTES, stream);
    Args a{};
    for (int i = 0; i < 17; ++i) a.p.in[i] = (const float*)d_in[i];
    a.p.out = (float*)d_out; a.p.ws = (unsigned char*)d_ws;
#if MK_PER_PHASE
    for (int ph = 0; ph < NPHASE; ++ph) { a.ph_lo = ph; a.ph_hi = ph + 1; hipLaunchKernelGGL(fwd_kernel, dim3(grid), dim3(512), LDS_BYTES, stream, a); }
#else
    a.ph_lo = 0; a.ph_hi = NPHASE;
    hipLaunchKernelGGL(fwd_kernel, dim3(grid), dim3(512), LDS_BYTES, stream, a);
#endif
}
```
